# Optimizing an MI355X kernel written in HIP

```python
import math
import jax
import jax.numpy as jnp
from jax import lax
import numpy as np

D_MODEL = 1024
BATCH = 8
SEQ = 4096
DEPTH = 2

EPS = 1e-6
D_ATT = D_MODEL // 2
D_HY = D_MODEL - D_ATT
ATT_HEADS = 4
ATT_V_DIM = D_ATT // ATT_HEADS
ATT_QK_DIM = ATT_V_DIM // 2
ROPE_DIM = ATT_QK_DIM // 4
ROPE_THETA = 500000.0
Q_BLOCK = 128
HY_SHORT_CONV = 3
HY_EMB_BANDS = 16
HY_EMB_DIM = 1 + 2 * HY_EMB_BANDS
HY_FILTER_FF = 64
HY_TARGET = 1e-2
HY_FAST_DECAY = 0.3
HY_SLOW_DECAY = 1.5
HY_MIN_DECAY = math.log(HY_TARGET) / HY_SLOW_DECAY
HY_MAX_DECAY = math.log(HY_TARGET) / HY_FAST_DECAY
IN_EVEN = 3 * D_ATT + 3 * D_HY
ML_HEADS = 4
ML_V_DIM = D_MODEL // ML_HEADS
ML_QK_DIM = ML_V_DIM // 2
ML_CHUNK = 128
SHORT_CONV = 3
ML_QK_W = 2 * ML_HEADS * ML_QK_DIM
IN_ODD = ML_QK_W + 2 * D_MODEL + 4 * ML_HEADS
N_GROUPS = 4
EXPERTS_PER_GROUP = 8
N_EXPERTS = N_GROUPS * EXPERTS_PER_GROUP
TOP_K = 2
D_EXPERT = D_MODEL // 2
MOE_BLOCK = 128
N_EVEN = (DEPTH + 1) // 2
N_ODD = DEPTH // 2

kernel_name = 'hybrid_diffattn_hyena_mlstm_hmoe_encoder'


def rms_norm(x, g):
    xf = x.astype(jnp.float32)
    y = xf * lax.rsqrt(jnp.mean(xf * xf, axis=-1, keepdims=True) + EPS)
    return (y * g.astype(jnp.float32)).astype(x.dtype)


def centered_dwconv(x, w, b):
    k = w.shape[0]
    pad = k // 2
    s = x.shape[1]
    xp = jnp.pad(x, ((0, 0), (pad, pad), (0, 0)))
    out = b
    for j in range(k):
        out = out + xp[:, j:j + s] * w[j]
    return out


def rope_tables(seq):
    inv_freq = 1.0 / (ROPE_THETA ** (jnp.arange(0, ROPE_DIM, 2, dtype=jnp.float32) / ROPE_DIM))
    ang = jnp.arange(seq, dtype=jnp.float32)[:, None] * inv_freq[None, :]
    return jnp.cos(ang), jnp.sin(ang)


def partial_rope(x, cos, sin):
    half = ROPE_DIM // 2
    x1 = x[..., :half]
    x2 = x[..., half:ROPE_DIM]
    c = cos.astype(x.dtype)
    s = sin.astype(x.dtype)
    return jnp.concatenate([x1 * c - x2 * s, x2 * c + x1 * s, x[..., ROPE_DIM:]], axis=-1)


def diff_attention(u, q_norm, k_norm, lam_q1, lam_k1, lam_q2, lam_k2, subln, lambda_init, cos, sin):
    b, s, _ = u.shape
    h, dk, dv = ATT_HEADS, ATT_QK_DIM, ATT_V_DIM
    q, k, v = jnp.split(u, 3, axis=-1)
    q = q.reshape(b, s, h, 2, dk).transpose(0, 2, 3, 1, 4)
    k = k.reshape(b, s, h, 2, dk).transpose(0, 2, 3, 1, 4)
    v = v.reshape(b, s, h, dv).transpose(0, 2, 1, 3)
    q = partial_rope(rms_norm(q, q_norm), cos, sin) * (dk ** -0.5)
    k = partial_rope(rms_norm(k, k_norm), cos, sin)
    f32 = jnp.float32
    lam = (jnp.exp(jnp.sum(lam_q1.astype(f32) * lam_k1.astype(f32)))
           - jnp.exp(jnp.sum(lam_q2.astype(f32) * lam_k2.astype(f32))) + lambda_init)
    nb = s // Q_BLOCK
    qb = q.reshape(b, h, 2, nb, Q_BLOCK, dk).transpose(3, 0, 1, 2, 4, 5)

    def attend(q_blk):
        sc = jnp.einsum('bhcqd,bhckd->bhcqk', q_blk, k).astype(f32)
        p = jax.nn.softmax(sc, axis=-1)
        w = p[:, :, 0] - lam * p[:, :, 1]
        return jnp.einsum('bhqk,bhkd->bhqd', w.astype(v.dtype), v)

    o = lax.map(attend, qb)
    o = o.transpose(1, 0, 3, 2, 4).reshape(b, s, h, dv)
    o = rms_norm(o, subln) * (1.0 - lambda_init)
    return o.reshape(b, s, h * dv)


def hyena_filter(length, w1, b1, freq, w2, b2, w3):
    f32 = jnp.float32
    w1, b1, freq, w2, b2, w3 = (a.astype(f32) for a in (w1, b1, freq, w2, b2, w3))
    t = jnp.linspace(0.0, 1.0, length, dtype=f32)[:, None]
    bands = jnp.linspace(1e-4, HY_EMB_BANDS - 1, HY_EMB_BANDS, dtype=f32)[None, :]
    ang = (2.0 * math.pi / length) * jnp.arange(length, dtype=f32)[:, None] * bands
    z = jnp.concatenate([t, jnp.cos(ang), -jnp.sin(ang)], axis=-1)
    hdn = jnp.sin(freq * (z @ w1 + b1))
    hdn = jnp.sin(freq * (hdn @ w2 + b2))
    filt = hdn @ w3
    deltas = jnp.abs(jnp.linspace(HY_MIN_DECAY, HY_MAX_DECAY, D_HY, dtype=f32))
    decay = jnp.exp(-t * deltas[None, :])
    h_fwd = filt[:, :D_HY] * decay
    h_bwd = filt[:, D_HY:] * decay
    kern = jnp.concatenate([h_fwd.at[0].add(h_bwd[0]), jnp.zeros((1, D_HY), f32), h_bwd[:0:-1]], axis=0)
    return kern / (jnp.sum(jnp.abs(kern), axis=0, keepdims=True) + EPS)


def hyena_mixer(u, conv_w, conv_b, f_w1, f_b1, f_freq, f_w2, f_b2, f_w3, skip):
    length = u.shape[1]
    uc = centered_dwconv(u, conv_w, conv_b)
    x1, x2, v = jnp.split(uc, 3, axis=-1)
    z = (v * x2).astype(jnp.float32)
    kern = hyena_filter(length, f_w1, f_b1, f_freq, f_w2, f_b2, f_w3)
    n = 2 * length
    zf = jnp.fft.rfft(z, n=n, axis=1)
    kf = jnp.fft.rfft(kern, n=n, axis=0)
    y = jnp.fft.irfft(zf * kf[None], n=n, axis=1)[:, :length]
    y = y + z * skip.astype(jnp.float32)
    return (y * x1.astype(jnp.float32)).astype(u.dtype)


def mlstm_chunkwise(q, k, v, log_i, log_f):
    f32 = jnp.float32
    b, g, s, dk = q.shape
    dv = v.shape[-1]
    lc = ML_CHUNK
    nc = s // lc
    qc = jnp.moveaxis(q.astype(f32).reshape(b, g, nc, lc, dk), 2, 0)
    kc = jnp.moveaxis(k.astype(f32).reshape(b, g, nc, lc, dk), 2, 0)
    vc = jnp.moveaxis(v.astype(f32).reshape(b, g, nc, lc, dv), 2, 0)
    ic = jnp.moveaxis(log_i.astype(f32).reshape(b, g, nc, lc), 2, 0)
    fc = jnp.moveaxis(log_f.astype(f32).reshape(b, g, nc, lc), 2, 0)
    mask = jnp.tril(jnp.ones((lc, lc), dtype=bool))

    def step(carry, inp):
        c_st, n_st, m_st = carry
        qj, kj, vj, lij, lfj = inp
        bcum = jnp.cumsum(lfj, axis=-1)
        dmat = bcum[..., :, None] - bcum[..., None, :] + lij[..., None, :]
        dmat = jnp.where(mask, dmat, -jnp.inf)
        inter = bcum + m_st[..., None]
        m_t = jnp.maximum(inter, jnp.max(dmat, axis=-1))
        w_intra = jnp.exp(dmat - m_t[..., None])
        w_inter = jnp.exp(inter - m_t)
        sc = jnp.einsum('bgtd,bgsd->bgts', qj, kj) * w_intra
        num = (w_inter[..., None] * jnp.einsum('bgtd,bgde->bgte', qj, c_st)
               + jnp.einsum('bgts,bgse->bgte', sc, vj))
        den = w_inter * jnp.einsum('bgtd,bgd->bgt', qj, n_st) + jnp.sum(sc, axis=-1)
        h = num / jnp.maximum(jnp.abs(den), jnp.exp(-m_t))[..., None]
        b_last = bcum[..., -1]
        g_s = b_last[..., None] - bcum + lij
        m_next = jnp.maximum(b_last + m_st, jnp.max(g_s, axis=-1))
        a_prev = jnp.exp(b_last + m_st - m_next)
        kw = kj * jnp.exp(g_s - m_next[..., None])[..., None]
        c_new = a_prev[..., None, None] * c_st + jnp.einsum('bgsd,bgse->bgde', kw, vj)
        n_new = a_prev[..., None] * n_st + jnp.sum(kw, axis=2)
        return (c_new, n_new, m_next), h

    init = (jnp.zeros((b, g, dk, dv), f32), jnp.zeros((b, g, dk), f32), jnp.zeros((b, g), f32))
    _, hs = lax.scan(step, init, (qc, kc, vc, ic, fc))
    return jnp.moveaxis(hs, 0, 2).reshape(b, g, s, dv)


def mlstm_mixer(u, conv_w, conv_b, gate_b, out_norm):
    b, s, _ = u.shape
    h, dk, dv = ML_HEADS, ML_QK_DIM, ML_V_DIM
    qk, v, o, gates = jnp.split(u, [ML_QK_W, ML_QK_W + D_MODEL, ML_QK_W + 2 * D_MODEL], axis=-1)
    qk = jax.nn.silu(centered_dwconv(qk, conv_w, conv_b))
    q, k = jnp.split(qk, 2, axis=-1)
    q = q.reshape(b, s, h, dk).transpose(0, 2, 1, 3) * (dk ** -0.5)
    k = k.reshape(b, s, h, dk).transpose(0, 2, 1, 3)
    v = v.reshape(b, s, h, dv).transpose(0, 2, 1, 3)
    gates = (gates.astype(jnp.float32) + gate_b.astype(jnp.float32)).reshape(b, s, 4, h).transpose(0, 2, 3, 1)

    def flip(a):
        return jnp.flip(a, axis=2)

    log_i = jnp.concatenate([gates[:, 0], flip(gates[:, 2])], axis=1)
    log_f = jax.nn.log_sigmoid(jnp.concatenate([gates[:, 1], flip(gates[:, 3])], axis=1))
    hs = mlstm_chunkwise(jnp.concatenate([q, flip(q)], axis=1), jnp.concatenate([k, flip(k)], axis=1),
                         jnp.concatenate([v, flip(v)], axis=1), log_i, log_f)
    hsum = hs[:, :h] + flip(hs[:, h:])
    hsum = hsum.transpose(0, 2, 1, 3).astype(u.dtype)
    hsum = rms_norm(hsum, out_norm.reshape(h, dv)).reshape(b, s, D_MODEL)
    return hsum * jax.nn.sigmoid(o)


def hier_moe(x, wg, bg, we, be, w1, w3, w2):
    f32 = jnp.float32
    b, s, d = x.shape
    t = b * s
    xt = x.reshape(t, d)
    g_logits = (xt @ wg).astype(f32) + bg.astype(f32)
    g_prob = jax.nn.softmax(g_logits, axis=-1)
    g_idx = jnp.argmax(g_logits, axis=-1)
    g_w = jnp.take_along_axis(g_prob, g_idx[:, None], axis=-1)[:, 0]
    e_logits = ((xt @ we).astype(f32) + be.astype(f32)).reshape(t, N_GROUPS, EXPERTS_PER_GROUP)
    e_logits = jnp.take_along_axis(e_logits, g_idx[:, None, None], axis=1)[:, 0]
    top_p, top_e = lax.top_k(jax.nn.softmax(e_logits, axis=-1), TOP_K)
    top_p = top_p / jnp.sum(top_p, axis=-1, keepdims=True)
    gate = (g_w[:, None] * top_p).reshape(-1)
    eid = (g_idx[:, None] * EXPERTS_PER_GROUP + top_e).reshape(-1).astype(jnp.int32)
    tok = jnp.arange(t * TOP_K, dtype=jnp.int32) // TOP_K
    order = jnp.argsort(eid)
    se = eid[order]
    counts = jnp.bincount(eid, length=N_EXPERTS)
    starts = jnp.cumsum(counts) - counts
    padded = (counts + MOE_BLOCK - 1) // MOE_BLOCK * MOE_BLOCK
    pad_end = jnp.cumsum(padded)
    pad_start = pad_end - padded
    dest = pad_start[se] + (jnp.arange(t * TOP_K) - starts[se])
    cap = t * TOP_K + N_EXPERTS * MOE_BLOCK
    nb = cap // MOE_BLOCK
    buf_tok = jnp.zeros((cap,), jnp.int32).at[dest].set(tok[order])
    buf_gate = jnp.zeros((cap,), f32).at[dest].set(gate[order])
    blk_e = jnp.minimum(jnp.searchsorted(pad_end, jnp.arange(nb) * MOE_BLOCK, side='right'), N_EXPERTS - 1)
    xb = xt[buf_tok].reshape(nb, MOE_BLOCK, d)

    def expert_block(args):
        xe, e = args
        hid = jax.nn.silu(xe @ w1[e]) * (xe @ w3[e])
        return hid @ w2[e]

    yb = lax.map(expert_block, (xb, blk_e)).reshape(cap, d)
    out = jax.ops.segment_sum(yb.astype(f32) * buf_gate[:, None], buf_tok, num_segments=t)
    return out.astype(x.dtype).reshape(b, s, d)


def setup_inputs(seed: int = 0) -> dict:
    key = jax.random.key(seed)
    keys = iter(jax.random.split(key, 48))
    f32 = jnp.float32

    def normal(shape, scale):
        return jax.random.normal(next(keys), shape, f32) * scale

    def gain(shape):
        return 1.0 + normal(shape, 0.02)

    ne, no, d = N_EVEN, N_ODD, D_MODEL
    h = ML_HEADS
    f_bias = jnp.linspace(3.0, 6.0, h, dtype=f32)
    gate_b = jnp.concatenate([normal((no, h), 0.1), f_bias + normal((no, h), 0.1),
                              normal((no, h), 0.1), f_bias + normal((no, h), 0.1)], axis=-1)
    return {
        'x': normal((BATCH, SEQ, d), 1.0),
        'mix_norm': gain((DEPTH, d)),
        'ffn_norm': gain((DEPTH, d)),
        'ev_w_in': normal((ne, d, IN_EVEN), d ** -0.5),
        'ev_q_norm': gain((ne, ATT_QK_DIM)),
        'ev_k_norm': gain((ne, ATT_QK_DIM)),
        'ev_lam_q1': normal((ne, ATT_QK_DIM), 0.1),
        'ev_lam_k1': normal((ne, ATT_QK_DIM), 0.1),
        'ev_lam_q2': normal((ne, ATT_QK_DIM), 0.1),
        'ev_lam_k2': normal((ne, ATT_QK_DIM), 0.1),
        'ev_subln': gain((ne, ATT_V_DIM)),
        'ev_hy_conv_w': normal((ne, HY_SHORT_CONV, 3 * D_HY), HY_SHORT_CONV ** -0.5),
        'ev_hy_conv_b': normal((ne, 3 * D_HY), 0.02),
        'ev_hy_f_w1': normal((ne, HY_EMB_DIM, HY_FILTER_FF), HY_EMB_DIM ** -0.5),
        'ev_hy_f_b1': normal((ne, HY_FILTER_FF), 0.02),
        'ev_hy_f_freq': 1.0 + normal((ne, HY_FILTER_FF), 0.1),
        'ev_hy_f_w2': normal((ne, HY_FILTER_FF, HY_FILTER_FF), HY_FILTER_FF ** -0.5),
        'ev_hy_f_b2': normal((ne, HY_FILTER_FF), 0.02),
        'ev_hy_f_w3': normal((ne, HY_FILTER_FF, 2 * D_HY), HY_FILTER_FF ** -0.5),
        'ev_hy_skip': normal((ne, D_HY), 0.5),
        'ev_w_out': normal((ne, d, d), d ** -0.5),
        'od_w_in': normal((no, d, IN_ODD), d ** -0.5),
        'od_conv_w': normal((no, SHORT_CONV, ML_QK_W), SHORT_CONV ** -0.5),
        'od_conv_b': normal((no, ML_QK_W), 0.02),
        'od_gate_b': gate_b,
        'od_out_norm': gain((no, d)),
        'od_w_out': normal((no, d, d), d ** -0.5),
        'moe_wg': normal((DEPTH, d, N_GROUPS), d ** -0.5),
        'moe_bg': normal((DEPTH, N_GROUPS), 0.01),
        'moe_we': normal((DEPTH, d, N_EXPERTS), d ** -0.5),
        'moe_be': normal((DEPTH, N_EXPERTS), 0.01),
        'moe_w1': normal((DEPTH, N_EXPERTS, d, D_EXPERT), d ** -0.5),
        'moe_w3': normal((DEPTH, N_EXPERTS, d, D_EXPERT), d ** -0.5),
        'moe_w2': normal((DEPTH, N_EXPERTS, D_EXPERT, d), D_EXPERT ** -0.5),
    }


def reference(x, mix_norm, ffn_norm, ev_w_in, ev_q_norm, ev_k_norm, ev_lam_q1, ev_lam_k1, ev_lam_q2,
              ev_lam_k2, ev_subln, ev_hy_conv_w, ev_hy_conv_b, ev_hy_f_w1, ev_hy_f_b1, ev_hy_f_freq,
              ev_hy_f_w2, ev_hy_f_b2, ev_hy_f_w3, ev_hy_skip, ev_w_out, od_w_in, od_conv_w, od_conv_b,
              od_gate_b, od_out_norm, od_w_out, moe_wg, moe_bg, moe_we, moe_be, moe_w1, moe_w3, moe_w2):
    cos, sin = rope_tables(x.shape[1])
    for layer in range(DEPTH):
        j = layer // 2
        hn = rms_norm(x, mix_norm[layer])
        if layer % 2 == 0:
            u = hn @ ev_w_in[j]
            lambda_init = 0.8 - 0.6 * math.exp(-0.3 * layer)
            y_att = diff_attention(u[..., :3 * D_ATT], ev_q_norm[j], ev_k_norm[j], ev_lam_q1[j],
                                   ev_lam_k1[j], ev_lam_q2[j], ev_lam_k2[j], ev_subln[j],
                                   lambda_init, cos, sin)
            y_hy = hyena_mixer(u[..., 3 * D_ATT:], ev_hy_conv_w[j], ev_hy_conv_b[j], ev_hy_f_w1[j],
                               ev_hy_f_b1[j], ev_hy_f_freq[j], ev_hy_f_w2[j], ev_hy_f_b2[j],
                               ev_hy_f_w3[j], ev_hy_skip[j])
            y = jnp.concatenate([y_att, y_hy], axis=-1) @ ev_w_out[j]
        else:
            u = hn @ od_w_in[j]
            y = mlstm_mixer(u, od_conv_w[j], od_conv_b[j], od_gate_b[j], od_out_norm[j]) @ od_w_out[j]
        x = x + y
        x = x + hier_moe(rms_norm(x, ffn_norm[layer]), moe_wg[layer], moe_bg[layer], moe_we[layer],
                         moe_be[layer], moe_w1[layer], moe_w3[layer], moe_w2[layer])
    return x
```

```cpp
#include <hip/hip_runtime.h>
#include <hip/hip_cooperative_groups.h>
#include <cstdio>
#include <cstdint>

#define LAS __attribute__((address_space(3)))
#define GAS __attribute__((address_space(1)))
typedef unsigned short bf16;
typedef short bf16x8 __attribute__((ext_vector_type(8)));
typedef float f32x4 __attribute__((ext_vector_type(4)));
typedef float f32x2 __attribute__((ext_vector_type(2)));
typedef unsigned u32x4 __attribute__((ext_vector_type(4)));
typedef unsigned u32x2 __attribute__((ext_vector_type(2)));

#ifndef MK_ONE
#define MK_ONE 1
#endif

constexpr int BATCH = 8, SEQ = 4096, DM = 1024, NTOK = BATCH * SEQ, NU = 3072;
constexpr int NWAVES = 8, NTHR = 512;
constexpr float EPS = 1e-6f;
constexpr int N_PHASES = 18;
constexpr int LDS_BYTES = 160 * 1024;

constexpr size_t MiB = 1u << 20;
constexpr size_t WS_CTL = 0, CTL_BYTES = 64 * 1024;
constexpr size_t WS_ROPE = 1 * MiB;
constexpr size_t WS_HDN = 2 * MiB;
constexpr size_t WS_TAPS = 3 * MiB;
constexpr size_t WS_NRM = 30 * MiB;
constexpr size_t WS_GATES = 19 * MiB;
constexpr size_t WS_RSTD1 = 21 * MiB;
constexpr size_t WS_RINFO = 22 * MiB;
constexpr size_t WS_WIN0 = 32 * MiB, WS_WOUT0 = 38 * MiB, WS_WIN1 = 40 * MiB, WS_WOUT1 = 46 * MiB;
constexpr size_t WS_W13 = 48 * MiB, WS_W2 = 112 * MiB;
constexpr size_t WS_HN = 144 * MiB;
constexpr size_t WS_U = 208 * MiB;
constexpr size_t WS_Y = 208 * MiB;
constexpr size_t WS_HID = 336 * MiB;
constexpr size_t WS_SCR = 400 * MiB;
constexpr size_t WS_ZT = WS_SCR, WS_YT = WS_SCR + 32 * MiB, WS_KF = WS_SCR + 64 * MiB;
constexpr size_t WS_HF = WS_SCR, WS_HB = WS_SCR + 64 * MiB;
constexpr size_t WS_XB = WS_SCR + 48 * MiB;
constexpr size_t WS_END = 528 * MiB;
constexpr int CW_FFT = 48, CW_CUR0 = 64, CW_CUR1 = 128, CW_TCNT0 = 1024, CW_TCNT1 = 1536, CW_OPT0 = 2048, CW_OPT1 = 2304;
constexpr int MOE_CAP = 32768;

struct Args { const float* in[34]; float* out; unsigned char* ws; int ph_lo, ph_hi; };
struct DArgs {
    const char* ka; float* out; unsigned char* ws;
    template <int I> __device__ __forceinline__ const float* in() const { unsigned long long v;
        asm volatile("s_load_dwordx2 %0, %1, %2\n\ts_waitcnt lgkmcnt(0)" : "=s"(v) : "s"(ka), "n"(I * 8) : "memory"); return (const float*)(const GAS float*)v; }
};

__device__ __forceinline__ unsigned f2bf(float f) { unsigned u = __builtin_bit_cast(unsigned, f); return (u + 0x7fffu + ((u >> 16) & 1u)) >> 16; }
typedef __bf16 bf16x2_t __attribute__((ext_vector_type(2)));
__device__ __forceinline__ unsigned pk2(float lo, float hi) { f32x2 v = {lo, hi}; bf16x2_t b = __builtin_convertvector(v, bf16x2_t); return __builtin_bit_cast(unsigned, b); }
__device__ __forceinline__ float bflo(unsigned w) { return __builtin_bit_cast(float, w << 16); }
__device__ __forceinline__ float bfhi(unsigned w) { return __builtin_bit_cast(float, w & 0xffff0000u); }
__device__ __forceinline__ float bf2f(bf16 h) { return __builtin_bit_cast(float, (unsigned)h << 16); }
template <int CTRL> __device__ __forceinline__ float dpp_mov(float v) { return __builtin_bit_cast(float, __builtin_amdgcn_update_dpp(0, __builtin_bit_cast(int, v), CTRL, 0xf, 0xf, true)); }
__device__ __forceinline__ float quad_sum(float v) { v += dpp_mov<0xB1>(v); v += dpp_mov<0x4E>(v); return v; }
__device__ __forceinline__ float row16_sum(float v) { v = quad_sum(v); v += dpp_mov<0x141>(v); v += dpp_mov<0x140>(v); return v; }
__device__ __forceinline__ float wave_sum(float v) {
    v = row16_sum(v);
    v += __builtin_bit_cast(float, __builtin_amdgcn_update_dpp(0, __builtin_bit_cast(int, v), 0x142, 0xA, 0xF, false));
    v += __builtin_bit_cast(float, __builtin_amdgcn_update_dpp(0, __builtin_bit_cast(int, v), 0x143, 0xC, 0xF, false));
    return __builtin_bit_cast(float, __builtin_amdgcn_readlane(__builtin_bit_cast(int, v), 63));
}
__device__ __forceinline__ int opaque_tid() { int t = threadIdx.x; asm volatile("" : "+v"(t)); return t; }
#define LDS_WAIT() asm volatile("s_waitcnt lgkmcnt(0)" ::: "memory")
#define VM_WAIT() asm volatile("s_waitcnt vmcnt(0)" ::: "memory")
__device__ __forceinline__ float sigmoidf_(float x) { return __builtin_amdgcn_rcpf(1.f + __expf(-x)); }
__device__ __forceinline__ float siluf_(float x) { return x * __builtin_amdgcn_rcpf(1.f + __expf(-x)); }

namespace pg8 {
constexpr int BM = 256, BK = 64, HALF = 128, HTB = HALF * BK * 2, NXCD = 8, WGM = 8;
__host__ __device__ __forceinline__ int lds_byte(int r, int c) { const int st = (r >> 4) * 2 + (c >> 5), rr = r & 15, cc = c & 31, ob = rr * 64 + cc * 2; return st * 1024 + (ob ^ (((ob >> 9) & 1) << 5)); }
__host__ __device__ __forceinline__ void stage_rc(int b, int& R, int& C) { const int st = b / 1024, sb = b % 1024, swz = sb ^ (((sb >> 9) & 1) << 5); R = (st >> 1) * 16 + swz / 64; C = (st & 1) * 32 + (swz % 64) / 2; }
__host__ __device__ __forceinline__ int perm32(int rho) { const int n = rho >> 4, i = rho & 15; return 8 * (i >> 2) + 4 * n + (i & 3); }

struct Unit { const char* A; const char* B; int pm, pn, aux, nvalid; const int* rows; };

struct StaticOrder {
    int nM, nN, nwg, G, c;
    __device__ void init(int M, int N, int G_, int c_) { nM = M / BM; nN = N / BM; nwg = nM * nN; G = G_; c = c_; }
    __device__ bool next(int i, int& pm, int& pn) const {
        const long L = (long)i * G + c; if (L >= nwg) return false;
        int wgid = (int)L; { const int q = nwg / NXCD, r = nwg % NXCD, xcd = wgid % NXCD, off = wgid / NXCD; wgid = (xcd < r ? xcd * (q + 1) : r * (q + 1) + (xcd - r) * q) + off; }
        const int nig = WGM * nN, gid = wgid / nig, fm = gid * WGM, gsz = (nM - fm) < WGM ? (nM - fm) : WGM;
        pm = fm + ((wgid % nig) % gsz); pn = (wgid % nig) / gsz; return true;
    }
};
struct DenseSched {
    StaticOrder so; const char* A; const char* Bt; size_t tstep; unsigned* tcnt;
    __device__ void init(const bf16* A_, const bf16* Bt_, int M, int N, int K, int G, int c, unsigned* tcnt_ = nullptr) { so.init(M, N, G, c); A = (const char*)A_; Bt = (const char*)Bt_; tstep = (size_t)BM * K * 2; tcnt = tcnt_; }
    __device__ __forceinline__ bool next(int i, Unit& u) const { int pm, pn; if (!so.next(i, pm, pn)) return false; u.pm = pm; u.pn = pn; u.aux = 0; u.nvalid = 256; u.rows = nullptr; u.A = A + (size_t)pm * tstep; u.B = Bt + (size_t)pn * tstep; return true; }
    __device__ __forceinline__ void a_ready(const Unit&) const {}
    __device__ __forceinline__ void done(const Unit& u) const {
        if (tcnt == nullptr) return;
        asm volatile("s_waitcnt vmcnt(0)" ::: "memory");
        if ((threadIdx.x & 63) == 0) (void)__hip_atomic_fetch_add(tcnt + u.pm, 1u, __ATOMIC_RELAXED, __HIP_MEMORY_SCOPE_AGENT);
    }
};

template <class Epi, class Sched, bool GATHER>
__device__ __forceinline__ void gemm_phase(LAS unsigned char* lds, const int K, const Sched& S, const Epi& E) {
    const int tid = opaque_tid(), wid = __builtin_amdgcn_readfirstlane(tid >> 6), lane = tid & 63, wr = wid >> 2, wc = wid & 3, fr = lane & 15, fq = lane >> 4;
    const int nt = K / BK;
    unsigned voffA[2][2], voffAn[2][2], voffB[2]; int Rr[2], Cc[2];
#pragma unroll
    for (int i = 0; i < 2; ++i) { int R, C; stage_rc(tid * 16 + i * 8192, R, C); const int Rb = 64 * (R >> 5) + perm32(R & 31);
        Rr[i] = R; Cc[i] = C; voffB[i] = (unsigned)(Rb * K + C) * 2u;
        voffA[0][i] = (unsigned)(R * K + C) * 2u; voffA[1][i] = (unsigned)((R + HALF) * K + C) * 2u; voffAn[0][i] = voffA[0][i]; voffAn[1][i] = voffA[1][i]; }
    const size_t kstep = (size_t)(BK * 2);
    const size_t hstep = (size_t)32 * K * 2;
    const unsigned ldsw = (unsigned)wid * 1024u;
    const int aoff = lds_byte(wr * 64 + fr, fq * 8), boff = lds_byte(wc * 32 + fr, fq * 8);
#define PG8_SA(b, h) (((b) * 2 + (h)) * HTB)
#define PG8_SB(b, h) ((4 + (b) * 2 + (h)) * HTB)
#define PG8_STAGE(bufoff, gbase, voff) do { _Pragma("unroll") for (int _i = 0; _i < 2; ++_i) \
        __builtin_amdgcn_global_load_lds((const unsigned*)((const char*)(gbase) + (voff)[_i]), (LAS unsigned*)(lds + (bufoff) + ldsw + _i * 8192), 16, 0, 0); } while (0)
#define PG8_LDA(dst, b, h) do { _Pragma("unroll") for (int m = 0; m < 4; ++m) _Pragma("unroll") for (int k = 0; k < 2; ++k) dst[m][k] = *(const LAS bf16x8*)(lds + PG8_SA(b, h) + aoff + m * 2048 + k * 1024); } while (0)
#define PG8_LDB(dst, b, h) do { _Pragma("unroll") for (int n = 0; n < 2; ++n) _Pragma("unroll") for (int k = 0; k < 2; ++k) dst[n][k] = *(const LAS bf16x8*)(lds + PG8_SB(b, h) + boff + n * 2048 + k * 1024); } while (0)
#define PG8_MMA(ai, bj, At, Bt) do { __builtin_amdgcn_s_setprio(1); _Pragma("unroll") for (int m = 0; m < 4; ++m) _Pragma("unroll") for (int n = 0; n < 2; ++n) _Pragma("unroll") for (int k = 0; k < 2; ++k) \
        acc[ai][bj][m][n] = __builtin_amdgcn_mfma_f32_16x16x32_bf16(Bt[n][k], At[m][k], acc[ai][bj][m][n], 0, 0, 0); __builtin_amdgcn_s_setprio(0); } while (0)
#define PG8_WAIT_V(n) asm volatile("s_waitcnt vmcnt(" #n ")" ::: "memory")
#define PG8_WAIT_L(n) asm volatile("s_waitcnt lgkmcnt(" #n ")" ::: "memory")
#define PG8_BAR __builtin_amdgcn_s_barrier()
#define PG8_SCHED __builtin_amdgcn_sched_barrier(0)
#define PG8_GVOFF(dst, u) do { if constexpr (GATHER) { _Pragma("unroll") for (int _h = 0; _h < 2; ++_h) _Pragma("unroll") for (int _i = 0; _i < 2; ++_i) { \
        const int _r = _h * HALF + Rr[_i]; int _row = 0; if (_r < (u).nvalid) _row = (u).rows[2 * _r] >> 1; dst[_h][_i] = (unsigned)(_row * K + Cc[_i]) * 2u; } } } while (0)
    Unit cur, nxt; int ui = 0;
    if (!S.next(0, cur)) return;
    f32x4 acc[2][2][4][2];
#pragma unroll
    for (int a = 0; a < 2; ++a)
#pragma unroll
        for (int b = 0; b < 2; ++b)
#pragma unroll
            for (int m = 0; m < 4; ++m)
#pragma unroll
                for (int n = 0; n < 2; ++n) acc[a][b][m][n] = (f32x4){0.f, 0.f, 0.f, 0.f};
    bf16x8 At[4][2], B0[2][2], B1[2][2];
    const char* cA = cur.A; const char* cB = cur.B;
    S.a_ready(cur);
    PG8_GVOFF(voffA, cur);
    PG8_STAGE(PG8_SB(0, 0), cB, voffB); PG8_STAGE(PG8_SB(0, 1), cB + hstep, voffB); PG8_STAGE(PG8_SA(0, 0), cA, voffA[0]); PG8_STAGE(PG8_SA(0, 1), cA, voffA[1]);
    if (wr == 1) PG8_BAR;
    PG8_WAIT_V(2); PG8_BAR;
    PG8_STAGE(PG8_SB(1, 0), cB + kstep, voffB); PG8_STAGE(PG8_SA(1, 0), cA + kstep, voffA[0]); PG8_STAGE(PG8_SB(1, 1), cB + hstep + kstep, voffB);
    PG8_WAIT_V(6); PG8_BAR;
    for (;;) {
        const bool has_next = S.next(ui + 1, nxt);
        const char* nA = has_next ? nxt.A : cA; const char* nB = has_next ? nxt.B : cB;
        if constexpr (GATHER) { if (has_next) { PG8_GVOFF(voffAn, nxt); } else {
#pragma unroll
            for (int h = 0; h < 2; ++h)
#pragma unroll
                for (int i = 0; i < 2; ++i) voffAn[h][i] = voffA[h][i]; } }
        for (int t = 0; t < nt; t += 2) {
            const bool last = (t == nt - 2);
            if (last && has_next) S.a_ready(nxt);
            const char* a1 = cA + (size_t)(t + 1) * kstep;
            const char* a2 = last ? nA : cA + (size_t)(t + 2) * kstep; const char* b2 = last ? nB : cB + (size_t)(t + 2) * kstep;
            const char* a3 = a2 + kstep; const char* b3 = b2 + kstep;
            unsigned va2[2][2];
#pragma unroll
            for (int h = 0; h < 2; ++h)
#pragma unroll
                for (int i = 0; i < 2; ++i) va2[h][i] = (GATHER && last) ? voffAn[h][i] : voffA[h][i];
            PG8_LDB(B0, 0, 0); PG8_LDB(B1, 0, 1); PG8_SCHED; PG8_LDA(At, 0, 0); PG8_STAGE(PG8_SA(1, 1), a1, voffA[1]);
            PG8_WAIT_V(8); PG8_WAIT_L(0); PG8_BAR; PG8_MMA(0, 0, At, B0); PG8_MMA(0, 1, At, B1); PG8_BAR; PG8_SCHED;
            PG8_LDA(At, 0, 1); PG8_STAGE(PG8_SB(0, 0), b2, voffB); PG8_STAGE(PG8_SB(0, 1), b2 + hstep, voffB); PG8_STAGE(PG8_SA(0, 0), a2, va2[0]);
            PG8_WAIT_V(8); PG8_WAIT_L(0); PG8_BAR; PG8_MMA(1, 0, At, B0); PG8_MMA(1, 1, At, B1); PG8_BAR; PG8_SCHED;
            PG8_LDB(B0, 1, 0); PG8_LDB(B1, 1, 1); PG8_SCHED; PG8_LDA(At, 1, 0); PG8_STAGE(PG8_SA(0, 1), a2, va2[1]);
            PG8_WAIT_V(8); PG8_WAIT_L(0); PG8_BAR; PG8_MMA(0, 0, At, B0); PG8_MMA(0, 1, At, B1); PG8_BAR; PG8_SCHED;
            PG8_LDA(At, 1, 1); PG8_STAGE(PG8_SB(1, 0), b3, voffB); PG8_STAGE(PG8_SB(1, 1), b3 + hstep, voffB); PG8_STAGE(PG8_SA(1, 0), a3, va2[0]);
            PG8_WAIT_V(8); PG8_WAIT_L(0); PG8_BAR; PG8_MMA(1, 0, At, B0); PG8_MMA(1, 1, At, B1); PG8_BAR; PG8_SCHED;
        }
        if (wr == 0) PG8_BAR;
        E(acc, cur, wr, wc, fr, fq); S.done(cur);
        if (!has_next) break;
#pragma unroll
        for (int a = 0; a < 2; ++a)
#pragma unroll
            for (int b = 0; b < 2; ++b)
#pragma unroll
                for (int m = 0; m < 4; ++m)
#pragma unroll
                    for (int n = 0; n < 2; ++n) acc[a][b][m][n] = (f32x4){0.f, 0.f, 0.f, 0.f};
        cur = nxt; cA = nA; cB = nB; ++ui;
        if (wr == 1) PG8_BAR;
        if constexpr (GATHER) {
#pragma unroll
            for (int h = 0; h < 2; ++h)
#pragma unroll
                for (int i = 0; i < 2; ++i) voffA[h][i] = voffAn[h][i]; }
    }
    PG8_WAIT_V(0);
    PG8_BAR;
#undef PG8_SA
#undef PG8_SB
#undef PG8_STAGE
#undef PG8_LDA
#undef PG8_LDB
#undef PG8_MMA
#undef PG8_WAIT_V
#undef PG8_WAIT_L
#undef PG8_BAR
#undef PG8_SCHED
#undef PG8_GVOFF
}

struct EpiBf16 {
    bf16* O; int ldc;
    __device__ __forceinline__ void operator()(const f32x4 (&acc)[2][2][4][2], const Unit& u, int wr, int wc, int fr, int fq) const {
        const int row0 = u.pm * BM + wr * 64 + fr, col0 = u.pn * BM + wc * 64 + 8 * fq;
#pragma unroll
        for (int ai = 0; ai < 2; ++ai)
#pragma unroll
            for (int m = 0; m < 4; ++m) { bf16* rowp = O + (size_t)(row0 + ai * HALF + m * 16) * ldc + col0;
#pragma unroll
                for (int bj = 0; bj < 2; ++bj) { const f32x4 v0 = acc[ai][bj][m][0], v1 = acc[ai][bj][m][1];
                    u32x4 w; w.x = pk2(v0[0], v0[1]); w.y = pk2(v0[2], v0[3]); w.z = pk2(v1[0], v1[1]); w.w = pk2(v1[2], v1[3]);
                    *(u32x4*)(rowp + bj * 32) = w; } }
    }
};
struct EpiBf16RowScale {
    bf16* O; int ldc; const float* rs;
    __device__ __forceinline__ void operator()(const f32x4 (&acc)[2][2][4][2], const Unit& u, int wr, int wc, int fr, int fq) const {
        const int row0 = u.pm * BM + wr * 64 + fr, col0 = u.pn * BM + wc * 64 + 8 * fq;
        float sc[2][4];
#pragma unroll
        for (int ai = 0; ai < 2; ++ai)
#pragma unroll
            for (int m = 0; m < 4; ++m) sc[ai][m] = rs[row0 + ai * HALF + m * 16];
#pragma unroll
        for (int ai = 0; ai < 2; ++ai)
#pragma unroll
            for (int m = 0; m < 4; ++m) { bf16* rowp = O + (size_t)(row0 + ai * HALF + m * 16) * ldc + col0; const float q = sc[ai][m];
#pragma unroll
                for (int bj = 0; bj < 2; ++bj) { const f32x4 v0 = acc[ai][bj][m][0] * q, v1 = acc[ai][bj][m][1] * q;
                    u32x4 w; w.x = pk2(v0[0], v0[1]); w.y = pk2(v0[2], v0[3]); w.z = pk2(v1[0], v1[1]); w.w = pk2(v1[2], v1[3]);
                    *(u32x4*)(rowp + bj * 32) = w; } }
    }
};
struct EpiQKV0 {
    bf16* O; int ldc; const float* gq; const float* gk; const float* ct; const float* st;
    __device__ __forceinline__ void operator()(const f32x4 (&acc)[2][2][4][2], const Unit& u, int wr, int wc, int fr, int fq) const {
        const int row0 = u.pm * BM + wr * 64 + fr, col0 = u.pn * BM + wc * 64 + 8 * fq;
        if (u.pn >= 4) {
#pragma unroll
            for (int ai = 0; ai < 2; ++ai)
#pragma unroll
                for (int m = 0; m < 4; ++m) { bf16* rowp = O + (size_t)(row0 + ai * HALF + m * 16) * ldc + col0;
#pragma unroll
                    for (int bj = 0; bj < 2; ++bj) { const f32x4 v0 = acc[ai][bj][m][0], v1 = acc[ai][bj][m][1];
                        u32x4 w; w.x = pk2(v0[0], v0[1]); w.y = pk2(v0[2], v0[3]); w.z = pk2(v1[0], v1[1]); w.w = pk2(v1[2], v1[3]);
                        *(u32x4*)(rowp + bj * 32) = w; } }
            return; }
        const bool isq = u.pn < 2; const float* gs = (isq ? gq : gk) + 8 * fq;
        const f32x4 g00 = *(const f32x4*)gs, g01 = *(const f32x4*)(gs + 4), g10 = *(const f32x4*)(gs + 32), g11 = *(const f32x4*)(gs + 36);
        const float sc = isq ? 0.125f * 1.4426950408889634f : 1.f;
        const float sgn = (fq == 0) ? -1.f : 1.f; const bool ropel = fq < 2;
#pragma unroll
        for (int ai = 0; ai < 2; ++ai)
#pragma unroll
            for (int m = 0; m < 4; ++m) { const int row = row0 + ai * HALF + m * 16; const int spos = row & (SEQ - 1);
                f32x4 v00 = acc[ai][0][m][0], v01 = acc[ai][0][m][1], v10 = acc[ai][1][m][0], v11 = acc[ai][1][m][1];
                float ss = (v00[0] * v00[0] + v00[1] * v00[1]) + (v00[2] * v00[2] + v00[3] * v00[3]) + (v01[0] * v01[0] + v01[1] * v01[1]) + (v01[2] * v01[2] + v01[3] * v01[3])
                         + (v10[0] * v10[0] + v10[1] * v10[1]) + (v10[2] * v10[2] + v10[3] * v10[3]) + (v11[0] * v11[0] + v11[1] * v11[1]) + (v11[2] * v11[2] + v11[3] * v11[3]);
                { auto rr = __builtin_amdgcn_permlane16_swap(__float_as_uint(ss), __float_as_uint(ss), false, false); ss = __uint_as_float(rr[0]) + __uint_as_float(rr[1]); }
                { auto rr = __builtin_amdgcn_permlane32_swap(__float_as_uint(ss), __float_as_uint(ss), false, false); ss = __uint_as_float(rr[0]) + __uint_as_float(rr[1]); }
                const float rstd = __frsqrt_rn(ss * (1.f / 64.f) + EPS);
                v00 = v00 * rstd * g00; v01 = v01 * rstd * g01; v10 = v10 * rstd * g10; v11 = v11 * rstd * g11;
                const f32x4 c0 = *(const f32x4*)(ct + spos * 8), c1 = *(const f32x4*)(ct + spos * 8 + 4), s0 = *(const f32x4*)(st + spos * 8), s1 = *(const f32x4*)(st + spos * 8 + 4);
                f32x4 p0, p1;
#pragma unroll
                for (int j = 0; j < 4; ++j) {
                    { auto rr = __builtin_amdgcn_permlane16_swap(__float_as_uint(v00[j]), __float_as_uint(v00[j]), false, false); p0[j] = __uint_as_float((fq & 1) ? rr[0] : rr[1]); }
                    { auto rr = __builtin_amdgcn_permlane16_swap(__float_as_uint(v01[j]), __float_as_uint(v01[j]), false, false); p1[j] = __uint_as_float((fq & 1) ? rr[0] : rr[1]); } }
                if (ropel) { v00 = v00 * c0 + p0 * s0 * sgn; v01 = v01 * c1 + p1 * s1 * sgn; }
                v00 = v00 * sc; v01 = v01 * sc; v10 = v10 * sc; v11 = v11 * sc;
                bf16* rowp = O + (size_t)row * ldc + col0;
                u32x4 w; w.x = pk2(v00[0], v00[1]); w.y = pk2(v00[2], v00[3]); w.z = pk2(v01[0], v01[1]); w.w = pk2(v01[2], v01[3]);
                *(u32x4*)rowp = w;
                w.x = pk2(v10[0], v10[1]); w.y = pk2(v10[2], v10[3]); w.z = pk2(v11[0], v11[1]); w.w = pk2(v11[2], v11[3]);
                *(u32x4*)(rowp + 32) = w; }
    }
};
template <bool RES_F32> struct EpiResBf16 {
    const void* res; bf16* out; int ldc;
    __device__ __forceinline__ void operator()(const f32x4 (&acc)[2][2][4][2], const Unit& u, int wr, int wc, int fr, int fq) const {
        const int row0 = u.pm * BM + wr * 64 + fr, col0 = u.pn * BM + wc * 64 + 8 * fq;
#pragma unroll
        for (int ai = 0; ai < 2; ++ai)
#pragma unroll
            for (int m = 0; m < 4; ++m) { const size_t ro = (size_t)(row0 + ai * HALF + m * 16) * ldc + col0;
#pragma unroll
                for (int bj = 0; bj < 2; ++bj) { f32x4 r0, r1;
                    if (RES_F32) { const float* rp = (const float*)res + ro + bj * 32; r0 = *(const f32x4*)rp; r1 = *(const f32x4*)(rp + 4); }
                    else { const u32x4 w = *(const u32x4*)((const bf16*)res + ro + bj * 32); r0 = (f32x4){bflo(w.x), bfhi(w.x), bflo(w.y), bfhi(w.y)}; r1 = (f32x4){bflo(w.z), bfhi(w.z), bflo(w.w), bfhi(w.w)}; }
                    const f32x4 v0 = r0 + acc[ai][bj][m][0], v1 = r1 + acc[ai][bj][m][1];
                    u32x4 o; o.x = pk2(v0[0], v0[1]); o.y = pk2(v0[2], v0[3]); o.z = pk2(v1[0], v1[1]); o.w = pk2(v1[2], v1[3]);
                    asm volatile("global_store_dwordx4 %0, %1, off sc1\n\ts_nop 1" :: "v"(out + ro + bj * 32), "v"(o) : "memory"); } }
    }
};
struct EpiSwiGLU {
    bf16* H;
    __device__ __forceinline__ void operator()(const f32x4 (&acc)[2][2][4][2], const Unit& u, int wr, int wc, int fr, int fq) const {
        const int row0 = u.pm * BM + wr * 64 + fr, col0 = u.pn * 128 + wc * 32 + 8 * fq;
#pragma unroll
        for (int ai = 0; ai < 2; ++ai)
#pragma unroll
            for (int m = 0; m < 4; ++m) { bf16* rowp = H + (size_t)(row0 + ai * HALF + m * 16) * 512 + col0;
                float h[8];
#pragma unroll
                for (int n = 0; n < 2; ++n)
#pragma unroll
                    for (int j = 0; j < 4; ++j) { const float a = acc[ai][0][m][n][j], b = acc[ai][1][m][n][j]; h[n * 4 + j] = siluf_(a) * b; }
                u32x4 w; w.x = pk2(h[0], h[1]); w.y = pk2(h[2], h[3]); w.z = pk2(h[4], h[5]); w.w = pk2(h[6], h[7]);
                asm volatile("global_store_dwordx4 %0, %1, off sc1\n\ts_nop 1" :: "v"(rowp), "v"(w) : "memory"); }
    }
};
struct EpiMoeOut {
    bf16* Y;
    __device__ __forceinline__ void operator()(const f32x4 (&acc)[2][2][4][2], const Unit& u, int wr, int wc, int fr, int fq) const {
        const int col0 = u.pn * BM + wc * 64 + 8 * fq;
        int slot[2][4]; float gate[2][4];
#pragma unroll
        for (int ai = 0; ai < 2; ++ai)
#pragma unroll
            for (int m = 0; m < 4; ++m) { const int r = ai * HALF + wr * 64 + m * 16 + fr; slot[ai][m] = -1; gate[ai][m] = 0.f;
                if (r < u.nvalid) { slot[ai][m] = u.rows[2 * r]; gate[ai][m] = __builtin_bit_cast(float, u.rows[2 * r + 1]); } }
#pragma unroll
        for (int ai = 0; ai < 2; ++ai)
#pragma unroll
            for (int m = 0; m < 4; ++m) {
                if (slot[ai][m] >= 0) { const float g = gate[ai][m];
                    bf16* rowp = Y + (size_t)slot[ai][m] * 1024 + col0;
#pragma unroll
                    for (int bj = 0; bj < 2; ++bj) { const f32x4 v0 = acc[ai][bj][m][0] * g, v1 = acc[ai][bj][m][1] * g;
                        u32x4 w; w.x = pk2(v0[0], v0[1]); w.y = pk2(v0[2], v0[3]); w.z = pk2(v1[0], v1[1]); w.w = pk2(v1[2], v1[3]);
                        *(u32x4*)(rowp + bj * 32) = w; } } }
    }
};
struct MoeSched {
    const LAS int* tpre;
    const LAS int* cnt;
    const LAS int* xe;
    const int* rinfo;
    const char* A; const char* W; int K; size_t wstride_e; bool gather; int G, c, ntiles;
    unsigned* tcnt; int mode;
    __device__ __forceinline__ bool next(int i, Unit& u) const {
        const int nb = G >> 3, j0 = c >> 3, j = (mode == 2) ? nb - 1 - j0 : j0;
        const int un = i * nb + j, lt = un >> 2, pn = un & 3;
        int e = -1, local = 0, acc = 0;
#pragma unroll
        for (int k = 0; k < 4; ++k) { const int ek = __builtin_amdgcn_readfirstlane(xe[k]), nk = __builtin_amdgcn_readfirstlane(tpre[ek + 1]) - __builtin_amdgcn_readfirstlane(tpre[ek]);
            if (e < 0 && lt < acc + nk) { e = ek; local = lt - acc; } acc += nk; }
        if (e < 0) return false;
        const int t = __builtin_amdgcn_readfirstlane(tpre[e]) + local;
        u.pm = t; u.pn = pn; u.aux = e; u.nvalid = min(256, __builtin_amdgcn_readfirstlane(cnt[e]) - local * 256); u.rows = rinfo + ((size_t)e * MOE_CAP + (size_t)local * 256) * 2;
        u.A = gather ? A : A + (size_t)t * 256 * K * 2; u.B = W + (size_t)e * wstride_e + (size_t)pn * 256 * K * 2; return true;
    }
    __device__ __forceinline__ void a_ready(const Unit& u) const {
        if (mode != 2) return;
        if (threadIdx.x < 64) { unsigned polls = 0;
            while ((unsigned)__builtin_amdgcn_readfirstlane(__hip_atomic_load(tcnt + u.pm, __ATOMIC_RELAXED, __HIP_MEMORY_SCOPE_AGENT)) < 32u) { __builtin_amdgcn_s_sleep(2); if (++polls > (1u << 22)) break; }
            __builtin_amdgcn_fence(__ATOMIC_ACQUIRE, "agent");
            asm volatile("s_waitcnt vmcnt(0)" ::: "memory"); }
        asm volatile("" ::: "memory"); __builtin_amdgcn_s_barrier(); asm volatile("" ::: "memory");
    }
    __device__ __forceinline__ void done(const Unit& u) const {
        if (mode != 1) return;
        asm volatile("s_waitcnt vmcnt(0)" ::: "memory");
        if ((threadIdx.x & 63) == 0) (void)__hip_atomic_fetch_add(tcnt + u.pm, 1u, __ATOMIC_RELAXED, __HIP_MEMORY_SCOPE_AGENT);
    }
};
}

#define XP_LOAD(r, src, ldw) do { _Pragma("unroll") for (int _i = 0; _i < 32; ++_i) r[_i] = (src)[(size_t)(2 * _i + (lane >> 5)) * (ldw) + (lane & 31)]; } while (0)
#define XP_STORE(r, dst, Kdst) do { _Pragma("unroll") for (int _i = 0; _i < 32; ++_i) scr[(2 * _i + (lane >> 5)) * 33 + (lane & 31)] = r[_i]; \
    LDS_WAIT(); asm volatile("" ::: "memory"); } while (0)
#define XP_WRITE(dst, Kdst) do { const int _c = lane & 7; _Pragma("unroll") for (int _j = 0; _j < 4; ++_j) { const int _n = (lane >> 3) + 8 * _j; const LAS float* _s = scr + (8 * _c) * 33 + _n; \
    u32x4 _o; _o.x = pk2(_s[0 * 33], _s[1 * 33]); _o.y = pk2(_s[2 * 33], _s[3 * 33]); _o.z = pk2(_s[4 * 33], _s[5 * 33]); _o.w = pk2(_s[6 * 33], _s[7 * 33]); \
    *(u32x4*)((dst) + (size_t)_n * (Kdst) + 8 * _c) = _o; } LDS_WAIT(); asm volatile("" ::: "memory"); } while (0)
__device__ __forceinline__ void moe_item_desc(const float* w1, const float* w3, const float* w2, bf16* W13, bf16* W2, int it, const float*& src, int& ldw, bf16*& dst, int& Kdst) {
    const int e = it / 768, r = it % 768;
    if (r < 512) { const int rr = r & 255, kb = rr >> 4, nb = rr & 15, n0 = 32 * nb, k0 = 64 * kb; const int drow0 = 256 * (n0 >> 7) + 64 * ((n0 & 127) >> 5) + (r < 256 ? 0 : 32);
        src = (r < 256 ? w1 : w3) + (size_t)e * 1024 * 512 + (size_t)k0 * 512 + n0; ldw = 512; dst = W13 + (size_t)e * 1024 * 1024 + (size_t)drow0 * 1024 + k0; Kdst = 1024; }
    else { const int rr = r - 512, kb = rr >> 5, nb = rr & 31, k0 = 64 * kb, n0 = 32 * nb;
        src = w2 + (size_t)e * 512 * 1024 + (size_t)k0 * 1024 + n0; ldw = 1024; dst = W2 + (size_t)e * 1024 * 512 + (size_t)n0 * 512 + k0; Kdst = 512; }
}
__device__ __forceinline__ void moe_convert_items(const DArgs& a, int L, LAS float* scr, int gw, int ngw, int lane) {
    const float* w1 = a.in<31>() + (size_t)L * 32 * 1024 * 512; const float* w3 = a.in<32>() + (size_t)L * 32 * 1024 * 512; const float* w2 = a.in<33>() + (size_t)L * 32 * 512 * 1024;
    bf16* W13 = (bf16*)(a.ws + WS_W13); bf16* W2 = (bf16*)(a.ws + WS_W2);
    float r[32]; const float* src; int ldw; bf16* dst; int Kdst;
    if (gw >= 32 * 768) return;
    moe_item_desc(w1, w3, w2, W13, W2, gw, src, ldw, dst, Kdst); XP_LOAD(r, src, ldw);
    for (int it = gw; it < 32 * 768; it += ngw) {
        XP_STORE(r, dst, Kdst);
        bf16* dcur = dst; const int kcur = Kdst;
        if (it + ngw < 32 * 768) { moe_item_desc(w1, w3, w2, W13, W2, it + ngw, src, ldw, dst, Kdst); XP_LOAD(r, src, ldw); }
        XP_WRITE(dcur, kcur);
    }
}
__device__ __forceinline__ void dense_item_desc(const float* wi0, const float* wo0, const float* wi1, const float* wo1, unsigned char* ws, int it, const float*& src, int& ldw, bf16*& dst, int& ksc) {
    ksc = -1;
    if (it < 1536) { const int kb = it / 96, nb = it % 96; src = wi0 + (size_t)(64 * kb) * 3072 + 32 * nb; ldw = 3072; dst = (bf16*)(ws + WS_WIN0) + (size_t)(32 * nb) * 1024 + 64 * kb; }
    else if (it < 2048) { const int r = it - 1536, kb = r / 32, nb = r % 32; src = wo0 + (size_t)(64 * kb) * 1024 + 32 * nb; ldw = 1024; dst = (bf16*)(ws + WS_WOUT0) + (size_t)(32 * nb) * 1024 + 64 * kb; }
    else if (it < 3584) { const int r = it - 2048, kb = r / 96, nb = r % 96; src = wi1 + (size_t)(64 * kb) * 3088 + 32 * nb; ldw = 3088; dst = (bf16*)(ws + WS_WIN1) + (size_t)(32 * nb) * 1024 + 64 * kb; ksc = 64 * kb; }
    else { const int r = it - 3584, kb = r / 32, nb = r % 32; src = wo1 + (size_t)(64 * kb) * 1024 + 32 * nb; ldw = 1024; dst = (bf16*)(ws + WS_WOUT1) + (size_t)(32 * nb) * 1024 + 64 * kb; }
}
__device__ __forceinline__ void dense_convert_items(const DArgs& a, LAS float* scr, int gw, int ngw, int lane) {
    const float* wi0 = a.in<3>(); const float* wo0 = a.in<20>(); const float* wi1 = a.in<21>(); const float* wo1 = a.in<26>(); const float* g1 = a.in<1>() + 1024;
    float r[32]; const float* src; int ldw; bf16* dst; int ksc;
    if (gw >= 4096) return;
    dense_item_desc(wi0, wo0, wi1, wo1, a.ws, gw, src, ldw, dst, ksc); XP_LOAD(r, src, ldw);
    for (int it = gw; it < 4096; it += ngw) {
        if (ksc >= 0) {
#pragma unroll
            for (int i = 0; i < 32; ++i) r[i] *= g1[ksc + 2 * i + (lane >> 5)]; }
        XP_STORE(r, dst, 1024);
        bf16* dcur = dst;
        if (it + ngw < 4096) { dense_item_desc(wi0, wo0, wi1, wo1, a.ws, it + ngw, src, ldw, dst, ksc); XP_LOAD(r, src, ldw); }
        XP_WRITE(dcur, 1024);
    }
}
__device__ __forceinline__ float rms_row(f32x4 (&v)[4], const float* g, int lane) {
    float s = 0.f;
#pragma unroll
    for (int j = 0; j < 4; ++j) s += (v[j].x * v[j].x + v[j].y * v[j].y) + (v[j].z * v[j].z + v[j].w * v[j].w);
    const float rstd = __frsqrt_rn(wave_sum(s) * (1.f / DM) + EPS);
#pragma unroll
    for (int j = 0; j < 4; ++j) { const f32x4 gg = *(const f32x4*)(g + 4 * lane + 256 * j); v[j] = v[j] * rstd * gg; }
    return rstd;
}
__device__ __forceinline__ void store_row_bf16(bf16* orow, const f32x4 (&v)[4], int lane) {
#pragma unroll
    for (int j = 0; j < 4; ++j) { u32x2 w; w.x = pk2(v[j].x, v[j].y); w.y = pk2(v[j].z, v[j].w); *(u32x2*)(orow + 4 * lane + 256 * j) = w; }
}

__device__ __forceinline__ void load_row_bf16(const bf16* row, int lane, u32x2 (&w)[4]) {
#pragma unroll
    for (int j = 0; j < 4; ++j) w[j] = *(const u32x2*)(row + 4 * lane + 256 * j);
}
__device__ __forceinline__ void add_row_bf16(f32x4 (&v)[4], const u32x2 (&w)[4]) {
#pragma unroll
    for (int j = 0; j < 4; ++j) { v[j].x += bflo(w[j].x); v[j].y += bfhi(w[j].x); v[j].z += bflo(w[j].y); v[j].w += bfhi(w[j].y); }
}
__device__ __forceinline__ void phase_prep0(const DArgs& a, LAS unsigned char* lds, int vcu, int G) {
    const int tid = opaque_tid(), lane = tid & 63, wave = tid >> 6;
    LAS float* scr = (LAS float*)(lds + wave * 16384);
    const int gw = vcu * NWAVES + wave, ngw = G * NWAVES;
    unsigned char* ws = a.ws;
    dense_convert_items(a, scr, gw, ngw, lane);
    moe_convert_items(a, 0, scr, gw, ngw, lane);
    { float* ct = (float*)(ws + WS_ROPE); float* st = ct + SEQ * 8;
      for (int i = vcu * NTHR + tid; i < SEQ * 8; i += G * NTHR) { const int s = i >> 3, k = i & 7;
          const float inv = 1.0f / powf(500000.0f, (float)(2 * k) / 16.0f); const float ang = (float)s * inv; ct[i] = cosf(ang); st[i] = sinf(ang); } }
    { const float* w1 = a.in<13>(); const float* b1 = a.in<14>(); const float* fr = a.in<15>(); const float* w2 = a.in<16>(); const float* b2 = a.in<17>();
      float* hd = (float*)(ws + WS_HDN);
      for (int t = gw; t < SEQ; t += ngw) {
          float zf = 0.f;
          if (lane == 0) zf = (float)t / (float)(SEQ - 1);
          else if (lane < 33) { const int k = (lane - 1) & 15; const float band = 1e-4f + (float)k * ((15.0f - 1e-4f) / 15.0f);
              const float ang = (6.283185307179586f / (float)SEQ) * (float)t * band; zf = (lane < 17) ? cosf(ang) : -sinf(ang); }
          float acc = b1[lane];
          for (int j = 0; j < 33; ++j) acc += __shfl(zf, j) * w1[j * 64 + lane];
          const float h1 = sinf(fr[lane] * acc);
          float acc2 = b2[lane];
          for (int j = 0; j < 64; ++j) acc2 += __shfl(h1, j) * w2[j * 64 + lane];
          hd[t * 64 + lane] = sinf(fr[lane] * acc2);
      } }
    { const float* x = a.in<0>(); const float* g = a.in<1>(); bf16* hn = (bf16*)(ws + WS_HN);
      f32x4 v[4], nx[4];
#pragma unroll
      for (int j = 0; j < 4; ++j) nx[j] = *(const f32x4*)(x + (size_t)gw * DM + 4 * lane + 256 * j);
      for (int m = gw; m < NTOK; m += ngw) {
#pragma unroll
          for (int j = 0; j < 4; ++j) v[j] = nx[j];
          if (m + ngw < NTOK) {
#pragma unroll
              for (int j = 0; j < 4; ++j) nx[j] = *(const f32x4*)(x + (size_t)(m + ngw) * DM + 4 * lane + 256 * j); }
          rms_row(v, g, lane); store_row_bf16(hn + (size_t)m * DM, v, lane); } }
}

__device__ __forceinline__ void hyena_taps(const DArgs& a, LAS unsigned char* lds, int vcu, int G) {
    const int tid = opaque_tid();
    const float* hd = (const float*)(a.ws + WS_HDN); const float* w3 = a.in<18>();
    float* taps = (float*)(a.ws + WS_TAPS); float* nrm = (float*)(a.ws + WS_NRM);
    LAS float* hs = (LAS float*)lds;
    LAS float* tl = hs + 1024;
    const float dmin = -3.0701134573253944f, dmax = -15.350567286626972f;
    float wa[64], wb[64];
#pragma unroll
    for (int j = 0; j < 64; ++j) { wa[j] = w3[j * 1024 + tid]; wb[j] = w3[j * 1024 + 512 + tid]; }
    const float delta = fabsf(dmin + (float)tid * ((dmax - dmin) / 511.0f));
    for (int it = vcu; it < SEQ / 16; it += G) {
        const int t0 = it * 16;
        __syncthreads();
        for (int i = tid; i < 1024; i += NTHR) hs[i] = hd[t0 * 64 + i];
        __syncthreads();
        float nacc = 0.f;
#pragma unroll 1
        for (int tt = 0; tt < 16; ++tt) { float f = 0.f, b = 0.f;
#pragma unroll
            for (int j4 = 0; j4 < 16; ++j4) { const f32x4 h = *(const LAS f32x4*)(hs + tt * 64 + 4 * j4);
                f += h.x * wa[4 * j4] + h.y * wa[4 * j4 + 1] + h.z * wa[4 * j4 + 2] + h.w * wa[4 * j4 + 3];
                b += h.x * wb[4 * j4] + h.y * wb[4 * j4 + 1] + h.z * wb[4 * j4 + 2] + h.w * wb[4 * j4 + 3]; }
            const int t = t0 + tt; const float dec = __expf(-((float)t / (float)(SEQ - 1)) * delta); f *= dec; b *= dec;
            nacc += (t == 0) ? fabsf(f + b) : (fabsf(f) + fabsf(b));
            tl[tid * 17 + tt] = f; tl[(512 + tid) * 17 + tt] = b; }
        nrm[it * 512 + tid] = nacc;
        __syncthreads();
        for (int i = tid; i < 4096; i += NTHR) { const int n = i >> 2, q4 = i & 3; const LAS float* sp = tl + n * 17 + q4 * 4;
            *(f32x4*)(taps + (size_t)n * SEQ + t0 + q4 * 4) = (f32x4){sp[0], sp[1], sp[2], sp[3]}; }
    }
    __syncthreads();
}

__device__ __forceinline__ void qk_norm_rope_row(bf16* p, const u32x4 w0, const u32x4 w1, const float* g, const f32x4 c0, const f32x4 c1, const f32x4 s0, const f32x4 s1, bool rope, float sc) {
    float v[16];
    v[0] = bflo(w0.x); v[1] = bfhi(w0.x); v[2] = bflo(w0.y); v[3] = bfhi(w0.y); v[4] = bflo(w0.z); v[5] = bfhi(w0.z); v[6] = bflo(w0.w); v[7] = bfhi(w0.w);
    v[8] = bflo(w1.x); v[9] = bfhi(w1.x); v[10] = bflo(w1.y); v[11] = bfhi(w1.y); v[12] = bflo(w1.z); v[13] = bfhi(w1.z); v[14] = bflo(w1.w); v[15] = bfhi(w1.w);
    float ss = 0.f;
#pragma unroll
    for (int i = 0; i < 16; ++i) ss += v[i] * v[i];
    ss = quad_sum(ss);
    const float rstd = __frsqrt_rn(ss * (1.f / 64.f) + EPS);
#pragma unroll
    for (int i = 0; i < 16; ++i) v[i] = v[i] * rstd * g[i];
    if (rope) { const float cc[8] = {c0.x, c0.y, c0.z, c0.w, c1.x, c1.y, c1.z, c1.w}, sn[8] = {s0.x, s0.y, s0.z, s0.w, s1.x, s1.y, s1.z, s1.w};
#pragma unroll
        for (int i = 0; i < 8; ++i) { const float x1 = v[i], x2 = v[8 + i]; v[i] = x1 * cc[i] - x2 * sn[i]; v[8 + i] = x2 * cc[i] + x1 * sn[i]; } }
    u32x4 o0, o1;
    o0.x = pk2(v[0] * sc, v[1] * sc); o0.y = pk2(v[2] * sc, v[3] * sc); o0.z = pk2(v[4] * sc, v[5] * sc); o0.w = pk2(v[6] * sc, v[7] * sc);
    o1.x = pk2(v[8] * sc, v[9] * sc); o1.y = pk2(v[10] * sc, v[11] * sc); o1.z = pk2(v[12] * sc, v[13] * sc); o1.w = pk2(v[14] * sc, v[15] * sc);
    *(u32x4*)p = o0; *(u32x4*)(p + 8) = o1;
}
__device__ __forceinline__ void phase_prep_mix0(const DArgs& a, LAS unsigned char* lds, int vcu, int G) {
    const int tid = opaque_tid(), lane = tid & 63, wave = tid >> 6;
    const int gw = vcu * NWAVES + wave, ngw = G * NWAVES;
    bf16* U = (bf16*)(a.ws + WS_U);
    const float* ct = (const float*)(a.ws + WS_ROPE); const float* st = ct + SEQ * 8;
    { const float* cw = a.in<11>(); const float* cb = a.in<12>();
      bf16* zt = (bf16*)(a.ws + WS_ZT);
      LAS float* tile = (LAS float*)(lds + wave * 16640);
      const int sl = lane >> 3, cg = lane & 7;
      if ((ngw & 7) == 0) {
          const int c = (gw & 7) * 64 + cg * 8;
          float wx[3][8], wv[3][8], bx[8], bv[8];
#pragma unroll
          for (int i = 0; i < 8; ++i) { bx[i] = cb[512 + c + i]; bv[i] = cb[1024 + c + i];
#pragma unroll
              for (int j = 0; j < 3; ++j) { wx[j][i] = cw[j * 1536 + 512 + c + i]; wv[j][i] = cw[j * 1536 + 1024 + c + i]; } }
          for (int it = gw; it < BATCH * 64 * 8; it += ngw) {
              const int b = it >> 9, stile = (it >> 3) & 63, s0 = stile * 64, c0 = (it & 7) * 64;
#pragma unroll 2
              for (int k = 0; k < 8; ++k) { const int s = s0 + 8 * k + sl;
                  float zx[8], zv[8];
#pragma unroll
                  for (int i = 0; i < 8; ++i) { zx[i] = bx[i]; zv[i] = bv[i]; }
#pragma unroll
                  for (int j = 0; j < 3; ++j) { const int sp = s + j - 1;
                      if (sp >= 0 && sp < SEQ) { const bf16* row = U + (size_t)(b * SEQ + sp) * NU + 1536;
                          const u32x4 xw = *(const u32x4*)(row + 512 + c), vw = *(const u32x4*)(row + 1024 + c);
                          const float xs[8] = {bflo(xw.x), bfhi(xw.x), bflo(xw.y), bfhi(xw.y), bflo(xw.z), bfhi(xw.z), bflo(xw.w), bfhi(xw.w)};
                          const float vs[8] = {bflo(vw.x), bfhi(vw.x), bflo(vw.y), bfhi(vw.y), bflo(vw.z), bfhi(vw.z), bflo(vw.w), bfhi(vw.w)};
#pragma unroll
                          for (int i = 0; i < 8; ++i) { zx[i] += xs[i] * wx[j][i]; zv[i] += vs[i] * wv[j][i]; } } }
#pragma unroll
                  for (int i = 0; i < 8; ++i) tile[(cg * 8 + i) * 65 + 8 * k + sl] = zx[i] * zv[i]; }
              LDS_WAIT(); asm volatile("" ::: "memory");
#pragma unroll 2
              for (int k = 0; k < 8; ++k) { const int cc = 8 * k + sl; const LAS float* tr = tile + cc * 65 + cg * 8;
                  u32x4 w; w.x = pk2(tr[0], tr[1]); w.y = pk2(tr[2], tr[3]); w.z = pk2(tr[4], tr[5]); w.w = pk2(tr[6], tr[7]);
                  *(u32x4*)(zt + ((size_t)(b * 512 + c0 + cc)) * SEQ + s0 + cg * 8) = w; }
              LDS_WAIT(); asm volatile("" ::: "memory");
          }
      }
    }
    __syncthreads();
}

namespace att {
using f32x16 = __attribute__((ext_vector_type(16))) float;
using s16x4  = __attribute__((ext_vector_type(4))) short;
constexpr int KVBLK = 64, QBLK = 32;
constexpr int SHM_V = KVBLK * 128 * 2, SHM_K = KVBLK * 128 * 2;

constexpr float THR = 8.f;
#define KSWZ(row, colB) ((row) * 256 + ((colB) ^ (((row) & 7) << 4)))
#define SBAR() __builtin_amdgcn_sched_barrier(0)
__device__ __forceinline__ int crow(int r, int hi) { return (r & 3) + 8 * (r >> 2) + 4 * hi; }
__device__ __forceinline__ unsigned cvtpk(float lo, float hi) { unsigned r; asm volatile("v_cvt_pk_bf16_f32 %0, %1, %2" : "=v"(r) : "v"(lo), "v"(hi)); return r; }
typedef __bf16 bf16x2_t __attribute__((ext_vector_type(2)));
__device__ __forceinline__ float dot_ones(unsigned w, float acc) { return __builtin_amdgcn_fdot2_f32_bf16(__builtin_bit_cast(bf16x2_t, w), __builtin_bit_cast(bf16x2_t, 0x3f803f80u), acc, false); }
template <bool SHIFT> __device__ __forceinline__ void partialSM(f32x16& p0, float sh) {
  if (SHIFT) {
#pragma unroll
    for (int r = 0; r < 16; ++r) p0[r] += sh; }
#pragma unroll
  for (int r = 0; r < 16; ++r) p0[r] = __builtin_amdgcn_exp2f(p0[r]);
}
template <bool SHIFT> __device__ __forceinline__ void finishSM(f32x16& p0, f32x16& p1, float sh, float& l_reg, bf16x8& pa0, bf16x8& pa1, bf16x8& pa2, bf16x8& pa3) {
  if (SHIFT) {
#pragma unroll
    for (int r = 0; r < 16; ++r) p1[r] += sh; }
#pragma unroll
  for (int r = 0; r < 16; ++r) p1[r] = __builtin_amdgcn_exp2f(p1[r]);
#define PK4(P, BASE, OUT) do { u32x4 w = {cvtpk(P[BASE + 0], P[BASE + 1]), cvtpk(P[BASE + 2], P[BASE + 3]), cvtpk(P[BASE + 4], P[BASE + 5]), cvtpk(P[BASE + 6], P[BASE + 7])}; \
    OUT = *reinterpret_cast<bf16x8*>(&w); } while (0)
  PK4(p0, 0, pa0); PK4(p0, 8, pa1); PK4(p1, 0, pa2); PK4(p1, 8, pa3);
#undef PK4
  float ps0 = 0.f, ps1 = 0.f;
  { const u32x4 q0 = *reinterpret_cast<const u32x4*>(&pa0), q1 = *reinterpret_cast<const u32x4*>(&pa1), q2 = *reinterpret_cast<const u32x4*>(&pa2), q3 = *reinterpret_cast<const u32x4*>(&pa3);
    ps0 = dot_ones(q0.x, ps0); ps1 = dot_ones(q0.y, ps1); ps0 = dot_ones(q0.z, ps0); ps1 = dot_ones(q0.w, ps1);
    ps0 = dot_ones(q1.x, ps0); ps1 = dot_ones(q1.y, ps1); ps0 = dot_ones(q1.z, ps0); ps1 = dot_ones(q1.w, ps1);
    ps0 = dot_ones(q2.x, ps0); ps1 = dot_ones(q2.y, ps1); ps0 = dot_ones(q2.z, ps0); ps1 = dot_ones(q2.w, ps1);
    ps0 = dot_ones(q3.x, ps0); ps1 = dot_ones(q3.y, ps1); ps0 = dot_ones(q3.z, ps0); ps1 = dot_ones(q3.w, ps1); }
  l_reg += ps0 + ps1;
}
__device__ __forceinline__ void qkt(f32x16& p0, f32x16& p1, const char* Ks, const bf16x8* qr, int r32, int hi, int cbase) {
  p0 = f32x16{}; p1 = f32x16{};
#pragma unroll
  for (int d0 = 0; d0 < 4; ++d0) { const int cb = cbase + (d0 * 16 + hi * 8) * 2;
    bf16x8 b0 = *reinterpret_cast<const bf16x8*>(Ks + KSWZ(r32, cb));
    bf16x8 b1 = *reinterpret_cast<const bf16x8*>(Ks + KSWZ(32 + r32, cb));
    p0 = __builtin_amdgcn_mfma_f32_32x32x16_bf16(b0, qr[d0], p0, 0, 0, 0);
    p1 = __builtin_amdgcn_mfma_f32_32x32x16_bf16(b1, qr[d0], p1, 0, 0, 0); }
}
__device__ __forceinline__ int v_st(int k, int c) { const int kk = (k & ~0xC) | ((k & 4) << 1) | ((k & 8) >> 1); return ((kk >> 3) * 4 + (c >> 5)) * 512 + ((kk & 7) * 32 + (c & 31)) * 2; }
__device__ __forceinline__ int v_rd_base(int lane) { return ((lane & 3) << 3) | (((lane >> 2) & 3) << 6) | (((lane >> 4) & 1) << 5) | (((lane >> 5) & 1) << 8); }
constexpr int v_rd_off(int d0, int ks, int half) { return d0 * 512 + ks * 4096 + half * 2048; }
template <int OFF> __device__ __forceinline__ s16x4 tr_read(int vb) {
  s16x4 r; asm volatile("ds_read_b64_tr_b16 %0, %1 offset:%2" : "=&v"(r) : "v"(vb), "i"(OFF) : "memory"); return r;
}
#define PVG_RD(G, A, B, C, D) do { A = tr_read<v_rd_off((G) >> 1, ((G) & 1) * 2, 0)>(vb); B = tr_read<v_rd_off((G) >> 1, ((G) & 1) * 2, 1)>(vb); \
    C = tr_read<v_rd_off((G) >> 1, ((G) & 1) * 2 + 1, 0)>(vb); D = tr_read<v_rd_off((G) >> 1, ((G) & 1) * 2 + 1, 1)>(vb); } while (0)
#define PVG_MM(G, A, B, C, D) do { __builtin_amdgcn_s_setprio(1); o[(G) >> 1] = __builtin_amdgcn_mfma_f32_32x32x16_bf16(((G) & 1) ? pa2 : pa0, PVPK(A, B), o[(G) >> 1], 0, 0, 0); \
    o[(G) >> 1] = __builtin_amdgcn_mfma_f32_32x32x16_bf16(((G) & 1) ? pa3 : pa1, PVPK(C, D), o[(G) >> 1], 0, 0, 0); __builtin_amdgcn_s_setprio(0); } while (0)
#define PVPK(L, H) (bf16x8){L[0], L[1], L[2], L[3], H[0], H[1], H[2], H[3]}
#define PV_W4() do { asm volatile("s_waitcnt lgkmcnt(4)" ::: "memory"); SBAR(); } while (0)
#define PV_W0() do { asm volatile("s_waitcnt lgkmcnt(0)" ::: "memory"); SBAR(); } while (0)
#define PV_PRE(vb_) do { const int vb = (vb_); PVG_RD(0, va0, va1, va2, va3); PVG_RD(1, vb0_, vb1_, vb2_, vb3_); } while (0)
__device__ __forceinline__ void pv_d0(f32x16* o, int vb, bf16x8 pa0, bf16x8 pa1, bf16x8 pa2, bf16x8 pa3, s16x4 a0, s16x4 a1, s16x4 a2, s16x4 a3, s16x4 b0, s16x4 b1, s16x4 b2, s16x4 b3) {
  asm volatile("s_waitcnt lgkmcnt(0)" ::: "memory"); SBAR();
  PVG_MM(0, a0, a1, a2, a3); PVG_RD(2, a0, a1, a2, a3);
  PVG_MM(1, b0, b1, b2, b3); PVG_RD(3, b0, b1, b2, b3);
  PV_W4(); PVG_MM(2, a0, a1, a2, a3); PVG_RD(4, a0, a1, a2, a3);
  PV_W4(); PVG_MM(3, b0, b1, b2, b3); PVG_RD(5, b0, b1, b2, b3);
  PV_W4(); PVG_MM(4, a0, a1, a2, a3); PVG_RD(6, a0, a1, a2, a3);
  PV_W4(); PVG_MM(5, b0, b1, b2, b3); PVG_RD(7, b0, b1, b2, b3);
  PV_W4(); PVG_MM(6, a0, a1, a2, a3);
  PV_W0(); PVG_MM(7, b0, b1, b2, b3);
}
#undef PVG_MM
#undef PVPK
#undef PV_W4
#undef PV_W0
__device__ __forceinline__ void glds16(const void* gsrc, unsigned lds_dst) { unsigned keep;
  asm volatile("s_mov_b32 %0, m0\n\ts_mov_b32 m0, %2\n\ts_nop 0\n\tglobal_load_lds_dwordx4 %1, off\n\ts_mov_b32 m0, %0" : "=&s"(keep) : "v"(gsrc), "s"(lds_dst) : "memory"); }
#define WAIT_BAR(N) asm volatile("s_waitcnt vmcnt(" #N ") lgkmcnt(0)\n\ts_barrier" ::: "memory")
constexpr int RING_K = 0, RING_V = 3 * SHM_K, OFF_WS2 = 3 * SHM_K + 3 * SHM_V, OFF_O2B = 0;
template <bool SHIFT> __device__ __forceinline__ void attn_unit(const bf16* __restrict__ Qb, const bf16* __restrict__ Kh, const bf16* __restrict__ Vh, bf16* __restrict__ Ob, float lam, float negM2, const float* __restrict__ subln, char* lds) {
  const int tid = opaque_tid(), wid = __builtin_amdgcn_readfirstlane(tid >> 6), lane = tid & 63, r32 = lane & 31, hi = lane >> 5, comp = wid >> 2, wq = wid & 3;
  const unsigned lds0 = (unsigned)(uintptr_t)lds;
  float* ws = (float*)(lds + OFF_WS2) + wid * 64; float* li_l = ws;
  float l_reg = 0; f32x16 o[4] = {}; bf16x8 qr[4];
  const float sh = __builtin_bit_cast(float, __builtin_amdgcn_readfirstlane(__builtin_bit_cast(int, negM2)));
  unsigned ksrc[2], vsrc[2];
#pragma unroll
  for (int i = 0; i < 2; ++i) { const int pc = wid * 2 + i;
    { const int row = 4 * pc + (lane >> 4), c = (lane & 15) ^ (row & 7); ksrc[i] = (unsigned)(row * NU + c * 8); }
    { const int st = 2 * pc + (lane >> 5), k = (st >> 2) * 8 + ((lane & 31) >> 2), c = (st & 3) * 32 + 8 * (lane & 3); vsrc[i] = (unsigned)(k * NU + c); } }
  const unsigned kdst = lds0 + RING_K + wid * 2048, vdst = lds0 + RING_V + wid * 2048;
#define DMA_K(t, slot) do { glds16(Kh + (long)(t) * KVBLK * NU + ksrc[0], (unsigned)__builtin_amdgcn_readfirstlane(kdst + (slot))); glds16(Kh + (long)(t) * KVBLK * NU + ksrc[1], (unsigned)__builtin_amdgcn_readfirstlane(kdst + (slot) + 1024)); } while (0)
#define DMA_V(t, slot) do { glds16(Vh + (long)(t) * KVBLK * NU + vsrc[0], (unsigned)__builtin_amdgcn_readfirstlane(vdst + (slot))); glds16(Vh + (long)(t) * KVBLK * NU + vsrc[1], (unsigned)__builtin_amdgcn_readfirstlane(vdst + (slot) + 1024)); } while (0)
  DMA_K(0, 0); DMA_V(0, 0); DMA_K(1, SHM_K);
  const bf16* Qw = Qb + (long)(wq * QBLK + r32) * NU + comp * 64 + hi * 8;
#pragma unroll
  for (int d0 = 0; d0 < 4; ++d0) qr[d0] = *reinterpret_cast<const bf16x8*>(Qw + d0 * 16);
  const int cbase = comp * 128;
  const int vb0 = (int)(lds0 + RING_V) + v_rd_base(lane);
  const char* Kring = lds + RING_K;
  f32x16 pA0, pA1, pB0, pB1; bf16x8 pa0, pa1, pa2, pa3; constexpr int NT = SEQ / KVBLK;
  asm volatile("s_waitcnt vmcnt(0)" ::: "memory");
  __builtin_amdgcn_s_barrier();
  DMA_K(2, 2 * SHM_K); DMA_V(1, SHM_V);
  qkt(pA0, pA1, Kring, qr, r32, hi, cbase);
  WAIT_BAR(4);
  int kc = SHM_K, kn2 = 0, vp = 0, vn2 = 2 * SHM_V;
#define ROT3(x) ((x) == 2 * SHM_K ? 0 : (x) + SHM_K)
  s16x4 va0, va1, va2, va3, vb0_, vb1_, vb2_, vb3_;
#define STEP(PX0, PX1, PY0, PY1, j) do { \
    PV_PRE(vb0 + vp); \
    if ((j) + 2 < NT) DMA_K((j) + 2, kn2); if ((j) + 1 < NT) DMA_V((j) + 1, vn2); \
    partialSM<SHIFT>(PY0, sh); SBAR();                      \
    qkt(PX0, PX1, Kring + kc, qr, r32, hi, cbase); \
    finishSM<SHIFT>(PY0, PY1, sh, l_reg, pa0, pa1, pa2, pa3); SBAR(); \
    pv_d0(o, vb0 + vp, pa0, pa1, pa2, pa3, va0, va1, va2, va3, vb0_, vb1_, vb2_, vb3_); \
    if ((j) + 2 < NT) { WAIT_BAR(4); } else if ((j) + 1 < NT) { WAIT_BAR(2); } else { WAIT_BAR(0); } \
    kc = ROT3(kc); kn2 = ROT3(kn2); vp = ROT3(vp); vn2 = ROT3(vn2); } while (0)
  for (int j = 1; j + 1 < NT; j += 2) { STEP(pB0, pB1, pA0, pA1, j); STEP(pA0, pA1, pB0, pB1, j + 1); }
  STEP(pB0, pB1, pA0, pA1, NT - 1);
  PV_PRE(vb0 + vp);
  partialSM<SHIFT>(pB0, sh);
  finishSM<SHIFT>(pB0, pB1, sh, l_reg, pa0, pa1, pa2, pa3); SBAR();
  pv_d0(o, vb0 + vp, pa0, pa1, pa2, pa3, va0, va1, va2, va3, vb0_, vb1_, vb2_, vb3_);
  { auto rr = __builtin_amdgcn_permlane32_swap(__float_as_uint(l_reg), __float_as_uint(l_reg), false, false); l_reg = __uint_as_float(rr[0]) + __uint_as_float(rr[1]); }
  if (hi == 0) li_l[r32] = l_reg; asm volatile("s_waitcnt lgkmcnt(0)" ::: "memory");
  float rli[16];
#pragma unroll
  for (int r = 0; r < 16; ++r) rli[r] = __builtin_amdgcn_rcpf(li_l[crow(r, hi)]);
  float* O2 = (float*)(lds + OFF_O2B) + wq * 32 * 128;
  __syncthreads();
  if (comp == 1) {
#pragma unroll
    for (int r = 0; r < 16; ++r)
#pragma unroll
      for (int d0 = 0; d0 < 4; ++d0) O2[crow(r, hi) * 128 + d0 * 32 + r32] = o[d0][r] * rli[r];
  }
  __syncthreads();
  if (comp == 0) {
    float ss[16];
#pragma unroll
    for (int r = 0; r < 16; ++r) { float acc = 0.f;
#pragma unroll
      for (int d0 = 0; d0 < 4; ++d0) { const float d = o[d0][r] * rli[r] - lam * O2[crow(r, hi) * 128 + d0 * 32 + r32]; o[d0][r] = d; acc += d * d; }
      ss[r] = acc; }
#pragma unroll
    for (int r = 0; r < 16; ++r) { float v = row16_sum(ss[r]); v += __shfl_xor(v, 16);
      ss[r] = __frsqrt_rn(v * (1.f / 128.f) + EPS) * 0.8f; }
    bf16* Ow = Ob + (long)(wq * QBLK) * DM;
#pragma unroll
    for (int r = 0; r < 16; ++r) { const int orow = crow(r, hi);
#pragma unroll
      for (int d0 = 0; d0 < 4; ++d0) Ow[(long)orow * DM + d0 * 32 + r32] = (bf16)(pk2(o[d0][r] * ss[r] * subln[d0 * 32 + r32], 0.f) & 0xffffu); }
  }
  asm volatile("s_waitcnt vmcnt(0)" ::: "memory");
  __syncthreads();
#undef DMA_K
#undef PVG_RD
#undef PV_PRE
#undef DMA_V
#undef ROT3
#undef STEP
}
#undef WAIT_BAR
#undef KSWZ
#undef SBAR
}


namespace fft {
__device__ __forceinline__ int pad(int n) { return n + (n >> 4); }
constexpr int BUF_BYTES = (8192 + 512) * 8;
__device__ __forceinline__ f32x2 cmul(f32x2 a, f32x2 b) { return (f32x2){a.x * b.x - a.y * b.y, a.x * b.y + a.y * b.x}; }
__device__ __forceinline__ f32x2 cis_rev(float rev) { return (f32x2){__builtin_amdgcn_cosf(rev), __builtin_amdgcn_sinf(rev)}; }
#define FFT_DFT4(x0, x1, x2, x3, y0, y1, y2, y3) do { const f32x2 s02 = x0 + x2, d02 = x0 - x2, s13 = x1 + x3, d13 = x1 - x3; \
    y0 = s02 + s13; y2 = s02 - s13; y1 = (f32x2){d02.x + d13.y, d02.y - d13.x}; y3 = (f32x2){d02.x - d13.y, d02.y + d13.x}; } while (0)
__device__ __forceinline__ void dft16(f32x2 (&u)[16]) {
    f32x2 w[16];
#pragma unroll
    for (int a = 0; a < 4; ++a) FFT_DFT4(u[a], u[a + 4], u[a + 8], u[a + 12], w[a], w[a + 4], w[a + 8], w[a + 12]);
    const float c1 = 0.9238795325112867f, s1 = 0.3826834323650898f, r2 = 0.7071067811865476f;
    w[5]  = cmul(w[5],  (f32x2){c1, -s1});
    w[9]  = cmul(w[9],  (f32x2){r2, -r2});
    w[13] = cmul(w[13], (f32x2){s1, -c1});
    w[6]  = cmul(w[6],  (f32x2){r2, -r2});
    w[10] = (f32x2){w[10].y, -w[10].x};
    w[14] = cmul(w[14], (f32x2){-r2, -r2});
    w[7]  = cmul(w[7],  (f32x2){s1, -c1});
    w[11] = cmul(w[11], (f32x2){-r2, -r2});
    w[15] = cmul(w[15], (f32x2){-c1, s1});
#pragma unroll
    for (int b = 0; b < 4; ++b) FFT_DFT4(w[4 * b], w[4 * b + 1], w[4 * b + 2], w[4 * b + 3], u[b], u[b + 4], u[b + 8], u[b + 12]);
}
template <int P, bool LOAD>
__device__ __forceinline__ void pass16(f32x2 (&u)[16], LAS f32x2* buf, int tid) {
    if (LOAD) { const LAS f32x2* bp = buf + pad(tid);
#pragma unroll
        for (int r = 0; r < 16; ++r) u[r] = bp[544 * r];
    }
    const int k = tid & (P - 1);
    if (P > 1) {
        const float rev = -(float)k * (1.0f / (16.0f * P));
        const f32x2 w1 = cis_rev(rev), w2 = cis_rev(2.f * rev), w4 = cis_rev(4.f * rev), w8 = cis_rev(8.f * rev);
        const f32x2 w3 = cmul(w1, w2), w5 = cmul(w4, w1), w6 = cmul(w4, w2), w7 = cmul(w4, w3);
        u[1] = cmul(u[1], w1); u[2] = cmul(u[2], w2); u[3] = cmul(u[3], w3); u[4] = cmul(u[4], w4); u[5] = cmul(u[5], w5); u[6] = cmul(u[6], w6); u[7] = cmul(u[7], w7);
        u[8] = cmul(u[8], w8); u[9] = cmul(u[9], cmul(w8, w1)); u[10] = cmul(u[10], cmul(w8, w2)); u[11] = cmul(u[11], cmul(w8, w3)); u[12] = cmul(u[12], cmul(w8, w4));
        u[13] = cmul(u[13], cmul(w8, w5)); u[14] = cmul(u[14], cmul(w8, w6)); u[15] = cmul(u[15], cmul(w8, w7));
    }
    dft16(u);
    if (LOAD) __syncthreads();
    const int j = (tid - k) * 16 + k;
    LAS f32x2* sp = buf + j + (tid - k) + (k >> 4);
    constexpr int MS = (P == 1) ? 1 : (P == 16) ? 17 : 272;
#pragma unroll
    for (int m = 0; m < 16; ++m) sp[MS * m] = u[m];
    __syncthreads();
}
__device__ __forceinline__ void pass2_final(f32x2 (&lo)[8], f32x2 (&hi)[8], const LAS f32x2* buf, int tid) {
    const LAS f32x2* bp = buf + pad(tid);
#pragma unroll
    for (int q = 0; q < 8; ++q) { const int i = tid + 512 * q; const f32x2 u0 = bp[544 * q], u1 = cmul(bp[544 * (q + 8)], cis_rev(-(float)i * (1.0f / 8192.0f)));
        lo[q] = u0 + u1; hi[q] = u0 - u1; }
}
__device__ __forceinline__ void fft8192(f32x2 (&u)[16], LAS f32x2* buf, int tid) {
    pass16<1, false>(u, buf, tid); pass16<16, true>(u, buf, tid); pass16<256, true>(u, buf, tid);
    f32x2 lo[8], hi[8]; pass2_final(lo, hi, buf, tid);
#pragma unroll
    for (int q = 0; q < 8; ++q) { u[q] = lo[q]; u[q + 8] = hi[q]; }
    __syncthreads();
}
}

__device__ __forceinline__ void phase_attn(const DArgs& a, char* lds, int vcu, int G) {
    const int lane = opaque_tid() & 63;
    const bf16* U = (const bf16*)(a.ws + WS_U); bf16* A2 = (bf16*)(a.ws + WS_HN);
    float lam;
    { const float* lq1 = a.in<6>(); const float* lk1 = a.in<7>(); const float* lq2 = a.in<8>(); const float* lk2 = a.in<9>();
      const float p1 = wave_sum(lq1[lane] * lk1[lane]), p2 = wave_sum(lq2[lane] * lk2[lane]); lam = __expf(p1) - __expf(p2) + 0.2f; }
    const float* subln = a.in<10>();
    float negM2;
    { const float* qn = a.in<4>(); const float* kn = a.in<5>(); float gq = fabsf(qn[lane]), gk = fabsf(kn[lane]);
#pragma unroll
      for (int o = 1; o < 64; o <<= 1) { gq = fmaxf(gq, __shfl_xor(gq, o)); gk = fmaxf(gk, __shfl_xor(gk, o)); }
      negM2 = -8.0f * gq * gk * 1.4426950408889634f; if (negM2 > -64.f) negM2 = 0.f; }
    for (int u = vcu; u < BATCH * 4 * 32; u += G) {
        const int qb = u & 31, h = (u >> 5) & 3, b = u >> 7;
        const bf16* rowb = U + (size_t)b * SEQ * NU;
        if (negM2 == 0.f) att::attn_unit<false>(rowb + (size_t)(qb * 128) * NU + h * 128, rowb + 512 + h * 128, rowb + 1024 + h * 128, A2 + (size_t)(b * SEQ + qb * 128) * DM + h * 128, lam, negM2, subln, lds);
        else att::attn_unit<true>(rowb + (size_t)(qb * 128) * NU + h * 128, rowb + 512 + h * 128, rowb + 1024 + h * 128, A2 + (size_t)(b * SEQ + qb * 128) * DM + h * 128, lam, negM2, subln, lds);
    }
}
__device__ __forceinline__ void phase_hyena_fft(const DArgs& a, LAS unsigned char* lds, int vcu, int G) {
    const int tid = opaque_tid();
    const bf16* zt = (const bf16*)(a.ws + WS_ZT); bf16* yt = (bf16*)(a.ws + WS_YT); const f32x2* Kf = (const f32x2*)(a.ws + WS_KF);
    LAS f32x2* buf = (LAS f32x2*)lds;
    unsigned* ctr = (unsigned*)(a.ws + WS_CTL) + CW_FFT; LAS int* nxt = (LAS int*)(lds + fft::BUF_BYTES + 128);
    const int nst = ((2048 / G) * 3) / 4, nstatic = nst * G;
    int k = 0;
    bf16 zr0[8], zr1[8];
#define FFT_ZLOAD(IT) do { const int c_ = (IT) >> 2, bp_ = (IT) & 3; const bf16* z0_ = zt + ((size_t)((2 * bp_) * 512 + c_)) * SEQ; const bf16* z1_ = zt + ((size_t)((2 * bp_ + 1) * 512 + c_)) * SEQ; \
        _Pragma("unroll") for (int r = 0; r < 8; ++r) { zr0[r] = z0_[tid + 512 * r]; zr1[r] = z1_[tid + 512 * r]; } } while (0)
    if (vcu < 2048) FFT_ZLOAD(vcu);
    for (int it = vcu; it < 2048; ++k) {
        int claim = 0;
        if (tid == 0) claim = (k + 1 < nst) ? vcu + (k + 1) * G : nstatic + (int)__hip_atomic_fetch_add(ctr, 1u, __ATOMIC_RELAXED, __HIP_MEMORY_SCOPE_AGENT);
        const int c = it >> 2, bp = it & 3;
        f32x2 u[16];
        const f32x2* kf = Kf + (size_t)c * 8192;
#pragma unroll
        for (int r = 0; r < 8; ++r) { u[r] = (f32x2){bf2f(zr0[r]), bf2f(zr1[r])}; u[r + 8] = (f32x2){0.f, 0.f}; }
        fft::fft8192(u, buf, tid);
        if (tid == 0) *nxt = claim;
#pragma unroll
        for (int r = 0; r < 16; ++r) { const f32x2 y = fft::cmul(u[r], kf[tid + 512 * r]); u[r] = (f32x2){y.x, -y.y}; }
        fft::pass16<1, false>(u, buf, tid);
        const int itn = __builtin_amdgcn_readfirstlane(*nxt);
        if (itn < 2048) FFT_ZLOAD(itn);
        fft::pass16<16, true>(u, buf, tid); fft::pass16<256, true>(u, buf, tid);
        bf16* y0 = yt + ((size_t)((2 * bp) * 512 + c)) * SEQ; bf16* y1 = yt + ((size_t)((2 * bp + 1) * 512 + c)) * SEQ;
        const LAS f32x2* lp = buf + fft::pad(tid);
#pragma unroll
        for (int q = 0; q < 8; ++q) { const int i = tid + 512 * q; const f32x2 u0 = lp[544 * q], u1 = fft::cmul(lp[544 * (q + 8)], fft::cis_rev(-(float)i * (1.0f / 8192.0f)));
            const f32x2 rres = u0 + u1; y0[i] = (bf16)f2bf(rres.x * (1.0f / 8192.0f)); y1[i] = (bf16)f2bf(-rres.y * (1.0f / 8192.0f)); }
        __syncthreads();
        it = itn;
    }
#undef FFT_ZLOAD
}
__device__ __forceinline__ void phase_hyena_kf(const DArgs& a, LAS unsigned char* lds, int vcu, int G) {
    const int tid = opaque_tid();
    const float* tf = (const float*)(a.ws + WS_TAPS); const float* tb = tf + 512 * SEQ; f32x2* Kf = (f32x2*)(a.ws + WS_KF);
    LAS f32x2* buf = (LAS f32x2*)lds;
    const float* nrm = (const float*)(a.ws + WS_NRM);
    LAS float* red = (LAS float*)(lds + fft::BUF_BYTES);
    for (int c = vcu; c < 512; c += G) {
        float part = (tid < SEQ / 16) ? nrm[tid * 512 + c] : 0.f;
        part = wave_sum(part);
        if ((tid & 63) == 0) red[tid >> 6] = part;
        __syncthreads();
        const float sc = 1.f / (((red[0] + red[1]) + (red[2] + red[3])) + EPS);
        f32x2 u[16];
#pragma unroll
        for (int r = 0; r < 8; ++r) { const int n0 = tid + 512 * r; float v = tf[c * SEQ + n0]; if (n0 == 0) v += tb[c * SEQ]; u[r] = (f32x2){v * sc, 0.f};
            const int n = 4096 + n0; u[r + 8] = (f32x2){(n == 4096) ? 0.f : tb[c * SEQ + 8192 - n] * sc, 0.f}; }
        fft::fft8192(u, buf, tid);
#pragma unroll
        for (int r = 0; r < 16; ++r) Kf[(size_t)c * 8192 + tid + 512 * r] = u[r];
    }
}

__device__ __forceinline__ void phase_post_mix0(const DArgs& a, LAS unsigned char* lds, int vcu, int G) {
    const int tid = opaque_tid(), lane = tid & 63, wave = tid >> 6;
    const int gw = vcu * NWAVES + wave, ngw = G * NWAVES;
    bf16* A2 = (bf16*)(a.ws + WS_HN);
    const bf16* U = (const bf16*)(a.ws + WS_U); const bf16* yt = (const bf16*)(a.ws + WS_YT);
    const float* cw = a.in<11>(); const float* cb = a.in<12>(); const float* skip = a.in<19>();
    LAS float* tile = (LAS float*)(lds + wave * 16640);
    const int sl = lane >> 3, cg = lane & 7;
    const int c = (gw & 7) * 64 + cg * 8;
    float w1[3][8], wx[3][8], wv[3][8], b1[8], bx[8], bv[8], sk[8];
#pragma unroll
    for (int i = 0; i < 8; ++i) { b1[i] = cb[c + i]; bx[i] = cb[512 + c + i]; bv[i] = cb[1024 + c + i]; sk[i] = skip[c + i];
#pragma unroll
        for (int j = 0; j < 3; ++j) { w1[j][i] = cw[j * 1536 + c + i]; wx[j][i] = cw[j * 1536 + 512 + c + i]; wv[j][i] = cw[j * 1536 + 1024 + c + i]; } }
    for (int it = gw; it < BATCH * 64 * 8; it += ngw) {
        const int b = it >> 9, stile = (it >> 3) & 63, s0 = stile * 64, c0 = (it & 7) * 64;
#pragma unroll 2
        for (int k = 0; k < 8; ++k) { const int cc = 8 * k + sl; const u32x4 w = *(const u32x4*)(yt + ((size_t)(b * 512 + c0 + cc)) * SEQ + s0 + cg * 8);
            LAS float* tr = tile + cc * 65 + cg * 8; tr[0] = bflo(w.x); tr[1] = bfhi(w.x); tr[2] = bflo(w.y); tr[3] = bfhi(w.y); tr[4] = bflo(w.z); tr[5] = bfhi(w.z); tr[6] = bflo(w.w); tr[7] = bfhi(w.w); }
        LDS_WAIT(); asm volatile("" ::: "memory");
#pragma unroll 2
        for (int k = 0; k < 8; ++k) { const int s = s0 + 8 * k + sl;
            float x1[8], zx[8], zv[8];
#pragma unroll
            for (int i = 0; i < 8; ++i) { x1[i] = b1[i]; zx[i] = bx[i]; zv[i] = bv[i]; }
#pragma unroll
            for (int j = 0; j < 3; ++j) { const int sp = s + j - 1;
                if (sp >= 0 && sp < SEQ) { const bf16* row = U + (size_t)(b * SEQ + sp) * NU + 1536;
                    const u32x4 aw = *(const u32x4*)(row + c), xw = *(const u32x4*)(row + 512 + c), vw = *(const u32x4*)(row + 1024 + c);
                    const float as[8] = {bflo(aw.x), bfhi(aw.x), bflo(aw.y), bfhi(aw.y), bflo(aw.z), bfhi(aw.z), bflo(aw.w), bfhi(aw.w)};
                    const float xs[8] = {bflo(xw.x), bfhi(xw.x), bflo(xw.y), bfhi(xw.y), bflo(xw.z), bfhi(xw.z), bflo(xw.w), bfhi(xw.w)};
                    const float vs[8] = {bflo(vw.x), bfhi(vw.x), bflo(vw.y), bfhi(vw.y), bflo(vw.z), bfhi(vw.z), bflo(vw.w), bfhi(vw.w)};
#pragma unroll
                    for (int i = 0; i < 8; ++i) { x1[i] += as[i] * w1[j][i]; zx[i] += xs[i] * wx[j][i]; zv[i] += vs[i] * wv[j][i]; } } }
            float r[8];
#pragma unroll
            for (int i = 0; i < 8; ++i) { const float y = tile[(cg * 8 + i) * 65 + 8 * k + sl]; r[i] = (y + zx[i] * zv[i] * sk[i]) * x1[i]; }
            u32x4 o; o.x = pk2(r[0], r[1]); o.y = pk2(r[2], r[3]); o.z = pk2(r[4], r[5]); o.w = pk2(r[6], r[7]);
            *(u32x4*)(A2 + (size_t)(b * SEQ + s) * DM + 512 + c) = o; }
        LDS_WAIT(); asm volatile("" ::: "memory");
    }
    __syncthreads();
}

__device__ __forceinline__ void phase_router(const DArgs& a, LAS unsigned char* lds, int layer, int vcu, int G) {
    const int tid = opaque_tid(), lane = tid & 63, wave = tid >> 6;
    constexpr int WP = 1032;
    LAS bf16* WH = (LAS bf16*)lds;
    LAS bf16* WL = WH + 36 * WP;
    LAS float* LG = (LAS float*)lds + wave * (16 * 37);
    LAS float* GNl = (LAS float*)(lds + 2 * 36 * WP * 2);
    LAS int* eidl = (LAS int*)(GNl + 1024);
    LAS float* gatel = (LAS float*)(eidl + 256);
    LAS int* rankl = (LAS int*)(gatel + 256);
    LAS int* basel = rankl + 256;
    LAS int* cntl = basel + 32;
    LAS float* BE = (LAS float*)(cntl + 32);
    const float* wg = a.in<27>() + (size_t)layer * 1024 * 4; const float* bg = a.in<28>() + layer * 4;
    const float* we = a.in<29>() + (size_t)layer * 1024 * 32; const float* be = a.in<30>() + layer * 32;
    const float* gn = a.in<2>() + layer * 1024;
    const bf16* xin = (const bf16*)(a.ws + WS_XB); bf16* hn = (bf16*)(a.ws + WS_HN);
    unsigned* cursor = (unsigned*)(a.ws + WS_CTL) + (layer ? CW_CUR1 : CW_CUR0);
    int* rinfo = (int*)(a.ws + WS_RINFO);
    const float bg0 = bg[0], bg1 = bg[1], bg2 = bg[2], bg3 = bg[3];
    const unsigned* otc = (const unsigned*)(a.ws + WS_CTL) + (layer ? CW_OPT1 : CW_OPT0);
    for (int blk = vcu; blk < NTOK / 128; blk += G) {
        for (int i = tid; i < 512 * 8; i += NTHR) { const int q = i & 7, kp = i >> 3;
            const f32x4 w0 = *(const f32x4*)(we + (size_t)(2 * kp) * 32 + 4 * q) * gn[2 * kp], w1 = *(const f32x4*)(we + (size_t)(2 * kp + 1) * 32 + 4 * q) * gn[2 * kp + 1];
#pragma unroll
            for (int j = 0; j < 4; ++j) { const unsigned h = pk2(w0[j], w1[j]); const unsigned l = pk2(w0[j] - bflo(h), w1[j] - bfhi(h));
                *(LAS unsigned*)(WH + (4 + 4 * q + j) * WP + 2 * kp) = h; *(LAS unsigned*)(WL + (4 + 4 * q + j) * WP + 2 * kp) = l; } }
        { const int kp = tid; const f32x4 w0 = *(const f32x4*)(wg + (size_t)(2 * kp) * 4) * gn[2 * kp], w1 = *(const f32x4*)(wg + (size_t)(2 * kp + 1) * 4) * gn[2 * kp + 1];
            GNl[2 * kp] = gn[2 * kp]; GNl[2 * kp + 1] = gn[2 * kp + 1];
#pragma unroll
            for (int j = 0; j < 4; ++j) { const unsigned h = pk2(w0[j], w1[j]); const unsigned l = pk2(w0[j] - bflo(h), w1[j] - bfhi(h));
                *(LAS unsigned*)(WH + j * WP + 2 * kp) = h; *(LAS unsigned*)(WL + j * WP + 2 * kp) = l; } }
        if (tid < 32) { BE[tid] = be[tid]; cntl[tid] = 0; }
        if (tid < 64) { unsigned polls = 0;
            while ((unsigned)__builtin_amdgcn_readfirstlane(__hip_atomic_load(otc + (blk >> 1), __ATOMIC_RELAXED, __HIP_MEMORY_SCOPE_AGENT)) < 32u) { __builtin_amdgcn_s_sleep(2); if (++polls > (1u << 22)) break; }
            __builtin_amdgcn_fence(__ATOMIC_ACQUIRE, "agent");
            asm volatile("s_waitcnt vmcnt(0)" ::: "memory"); }
        __syncthreads();
        const int t = lane & 15, kg = lane >> 4; const int m = blk * 128 + wave * 16 + t;
        const bf16* xrow = xin + (size_t)m * DM + 8 * kg; bf16* hrow = hn + (size_t)m * DM + 8 * kg;
        float ss = 0.f;
#pragma unroll 8
        for (int sI = 0; sI < 32; ++sI) { const u32x4 xw = *(const u32x4*)(xrow + 32 * sI);
            const float v0 = bflo(xw.x), v1 = bfhi(xw.x), v2 = bflo(xw.y), v3 = bfhi(xw.y), v4 = bflo(xw.z), v5 = bfhi(xw.z), v6 = bflo(xw.w), v7 = bfhi(xw.w);
            ss += (v0 * v0 + v1 * v1) + (v2 * v2 + v3 * v3) + (v4 * v4 + v5 * v5) + (v6 * v6 + v7 * v7); }
        { auto rr = __builtin_amdgcn_permlane16_swap(__float_as_uint(ss), __float_as_uint(ss), false, false); ss = __uint_as_float(rr[0]) + __uint_as_float(rr[1]); }
        { auto rr = __builtin_amdgcn_permlane32_swap(__float_as_uint(ss), __float_as_uint(ss), false, false); ss = __uint_as_float(rr[0]) + __uint_as_float(rr[1]); }
        const float rstd = __frsqrt_rn(ss * (1.f / DM) + EPS);
        f32x4 acc0 = {0.f, 0.f, 0.f, 0.f}, acc1 = acc0, acc2 = acc0;
        const int r0 = t, r1 = 16 + t, r2 = (32 + t) < 36 ? 32 + t : 35;
        const LAS bf16* bh0 = WH + r0 * WP + 8 * kg; const LAS bf16* bh1 = WH + r1 * WP + 8 * kg; const LAS bf16* bh2 = WH + r2 * WP + 8 * kg;
        constexpr int LO = 36 * WP;
        u32x4 xa[8], xb[8];
#pragma unroll
        for (int i = 0; i < 8; ++i) xa[i] = *(const u32x4*)(xrow + 32 * i);
#pragma unroll
        for (int c = 0; c < 4; ++c) {
            if (c < 3) {
#pragma unroll
                for (int i = 0; i < 8; ++i) xb[i] = *(const u32x4*)(xrow + 32 * (8 * (c + 1) + i)); }
#pragma unroll
            for (int i = 0; i < 8; ++i) { const int sI = 8 * c + i; const u32x4 xw = xa[i];
                const bf16x8 ax = *reinterpret_cast<const bf16x8*>(&xw);
                { const bf16x8 bh = *(const LAS bf16x8*)(bh0 + 32 * sI), bl = *(const LAS bf16x8*)(bh0 + LO + 32 * sI);
                  acc0 = __builtin_amdgcn_mfma_f32_16x16x32_bf16(ax, bh, acc0, 0, 0, 0); acc0 = __builtin_amdgcn_mfma_f32_16x16x32_bf16(ax, bl, acc0, 0, 0, 0); }
                { const bf16x8 bh = *(const LAS bf16x8*)(bh1 + 32 * sI), bl = *(const LAS bf16x8*)(bh1 + LO + 32 * sI);
                  acc1 = __builtin_amdgcn_mfma_f32_16x16x32_bf16(ax, bh, acc1, 0, 0, 0); acc1 = __builtin_amdgcn_mfma_f32_16x16x32_bf16(ax, bl, acc1, 0, 0, 0); }
                { const bf16x8 bh = *(const LAS bf16x8*)(bh2 + 32 * sI), bl = *(const LAS bf16x8*)(bh2 + LO + 32 * sI);
                  acc2 = __builtin_amdgcn_mfma_f32_16x16x32_bf16(ax, bh, acc2, 0, 0, 0); acc2 = __builtin_amdgcn_mfma_f32_16x16x32_bf16(ax, bl, acc2, 0, 0, 0); }
                const f32x4 g0 = *(const LAS f32x4*)(GNl + 32 * sI + 8 * kg), g1 = *(const LAS f32x4*)(GNl + 32 * sI + 8 * kg + 4);
                u32x4 hw; hw.x = pk2(bflo(xw.x) * rstd * g0.x, bfhi(xw.x) * rstd * g0.y); hw.y = pk2(bflo(xw.y) * rstd * g0.z, bfhi(xw.y) * rstd * g0.w);
                hw.z = pk2(bflo(xw.z) * rstd * g1.x, bfhi(xw.z) * rstd * g1.y); hw.w = pk2(bflo(xw.w) * rstd * g1.z, bfhi(xw.w) * rstd * g1.w);
                *(u32x4*)(hrow + 32 * sI) = hw; }
            __builtin_amdgcn_sched_barrier(0);
#pragma unroll
            for (int i = 0; i < 8; ++i) xa[i] = xb[i];
        }
        __syncthreads();
#pragma unroll
        for (int r = 0; r < 4; ++r) { LAS float* lr = LG + (4 * kg + r) * 37; lr[t] = acc0[r]; lr[16 + t] = acc1[r]; if (t < 4) lr[32 + t] = acc2[r]; }
        LDS_WAIT(); asm volatile("" ::: "memory");
        { const LAS float* lr = LG + t * 37; const int tl = wave * 16 + t;
            float gl[4] = {lr[0] * rstd + bg0, lr[1] * rstd + bg1, lr[2] * rstd + bg2, lr[3] * rstd + bg3};
            int gi = 0; float gm = gl[0];
#pragma unroll
            for (int n = 1; n < 4; ++n) if (gl[n] > gm) { gm = gl[n]; gi = n; }
            float gs = 0.f;
#pragma unroll
            for (int n = 0; n < 4; ++n) gs += __expf(gl[n] - gm);
            const float gwt = 1.f / gs;
            float el[8];
#pragma unroll
            for (int n = 0; n < 8; ++n) el[n] = lr[4 + gi * 8 + n] * rstd + BE[gi * 8 + n];
            int e1 = 0; float m1 = el[0];
#pragma unroll
            for (int n = 1; n < 8; ++n) if (el[n] > m1) { m1 = el[n]; e1 = n; }
            int e2 = -1; float m2 = -3.0e38f;
#pragma unroll
            for (int n = 0; n < 8; ++n) if (n != e1 && el[n] > m2) { m2 = el[n]; e2 = n; }
            const float p2 = __expf(m2 - m1), inv = 1.f / (1.f + p2);
            if (kg == 0) { eidl[2 * tl] = gi * 8 + e1; eidl[2 * tl + 1] = gi * 8 + e2; gatel[2 * tl] = gwt * inv; gatel[2 * tl + 1] = gwt * p2 * inv; } }
        __syncthreads();
        if (tid < 256) rankl[tid] = __hip_atomic_fetch_add(cntl + eidl[tid], 1, __ATOMIC_RELAXED, __HIP_MEMORY_SCOPE_WORKGROUP);
        __syncthreads();
        if (tid < 32) { int tq = tid; asm volatile("" : "+v"(tq));
            const int cnt = cntl[tq]; basel[tq] = cnt ? (int)atomicAdd(&cursor[tq], (unsigned)cnt) : 0; cntl[tq] = 0; }
        __syncthreads();
        if (tid < 256) { const int e = eidl[tid], pos = basel[e] + rankl[tid]; int* ri = rinfo + ((size_t)e * MOE_CAP + pos) * 2;
            ri[0] = (blk * 128) * 2 + tid; ri[1] = __builtin_bit_cast(int, gatel[tid]); }
        __syncthreads();
    }
}

__device__ __forceinline__ void phase_moe_gemm(const DArgs& a, LAS unsigned char* lds, int layer, int which, int G) {
    LAS int* tpre = (LAS int*)(lds + 131072 + 1024); LAS int* cntl = tpre + 64;
    const int* cnt = (const int*)((unsigned*)(a.ws + WS_CTL) + (layer ? CW_CUR1 : CW_CUR0));
    LAS int* xe = tpre + 40;
    if (threadIdx.x < 64) { const int lane = threadIdx.x;
        const int c = lane < 32 ? (int)__hip_atomic_load(cnt + lane, __ATOMIC_RELAXED, __HIP_MEMORY_SCOPE_AGENT) : 0; const int nt = (c + 255) >> 8;
        int p = nt;
        for (int d = 1; d < 32; d <<= 1) { const int o = __shfl_up(p, d); if (lane >= d) p += o; }
        int rk = 0;
#pragma unroll
        for (int i = 0; i < 32; ++i) { const int ni = __builtin_amdgcn_readlane(nt, i); rk += (ni > nt || (ni == nt && i < lane)) ? 1 : 0; }
        if (lane < 32) { cntl[lane] = c; tpre[lane + 1] = p;
            const int xr = rk < 8 ? rk : rk < 16 ? 15 - rk : rk < 24 ? rk - 16 : 31 - rk;
            if (xr == ((int)blockIdx.x & 7)) xe[rk >> 3] = lane; }
        if (lane == 0) tpre[0] = 0; }
    __syncthreads();
    pg8::MoeSched S; S.tpre = tpre; S.cnt = cntl; S.xe = xe; S.rinfo = (const int*)(a.ws + WS_RINFO); S.G = G; S.c = (int)blockIdx.x; S.ntiles = __builtin_amdgcn_readfirstlane(tpre[32]);
    S.tcnt = (unsigned*)(a.ws + WS_CTL) + (layer ? CW_TCNT1 : CW_TCNT0); S.mode = which + 1;
    if (which == 0) { S.A = (const char*)(a.ws + WS_HN); S.W = (const char*)(a.ws + WS_W13); S.K = 1024; S.wstride_e = (size_t)1024 * 1024 * 2; S.gather = true;
        pg8::EpiSwiGLU E{(bf16*)(a.ws + WS_HID)};
        pg8::gemm_phase<pg8::EpiSwiGLU, pg8::MoeSched, true>(lds, 1024, S, E); }
    else { S.A = (const char*)(a.ws + WS_HID); S.W = (const char*)(a.ws + WS_W2); S.K = 512; S.wstride_e = (size_t)1024 * 512 * 2; S.gather = false;
        pg8::EpiMoeOut E{(bf16*)(a.ws + WS_Y)};
        pg8::gemm_phase<pg8::EpiMoeOut, pg8::MoeSched, false>(lds, 512, S, E); }
}

__device__ __forceinline__ void phase_prep1(const DArgs& a, LAS unsigned char* lds, int vcu, int G) {
    const int tid = opaque_tid(), lane = tid & 63, wave = tid >> 6;
    const int gw = vcu * NWAVES + wave, ngw = G * NWAVES;
    constexpr int WP = 1032;
    LAS bf16* WH = (LAS bf16*)lds; LAS bf16* WL = WH + 16 * WP; LAS float* RS = (LAS float*)(lds + 2 * 16 * WP * 2) + wave * 16;
    const float* win = a.in<21>(); const float* g = a.in<1>() + 1024;
    for (int i = tid; i < 512 * 4; i += NTHR) { const int q = i & 3, kp = i >> 2;
        const f32x4 w0 = *(const f32x4*)(win + (size_t)(2 * kp) * 3088 + 3072 + 4 * q) * g[2 * kp], w1 = *(const f32x4*)(win + (size_t)(2 * kp + 1) * 3088 + 3072 + 4 * q) * g[2 * kp + 1];
#pragma unroll
        for (int j = 0; j < 4; ++j) { const unsigned h = pk2(w0[j], w1[j]); const unsigned l = pk2(w0[j] - bflo(h), w1[j] - bfhi(h));
            *(LAS unsigned*)(WH + (4 * q + j) * WP + 2 * kp) = h; *(LAS unsigned*)(WL + (4 * q + j) * WP + 2 * kp) = l; } }
    __syncthreads();
    const float* gb = a.in<24>(); float* rstd1 = (float*)(a.ws + WS_RSTD1); float* gates = (float*)(a.ws + WS_GATES);
    const bf16* X1 = (const bf16*)(a.ws + WS_XB); const bf16* Y = (const bf16*)(a.ws + WS_Y); bf16* X2 = (bf16*)a.out;
    const int t = lane & 15, kg = lane >> 4;
    const LAS bf16* bhp = WH + t * WP + 8 * kg; constexpr int LO = 16 * WP;
    for (int grp = gw; grp < NTOK / 16; grp += ngw) {
        const int m0 = grp * 16, m = m0 + t;
        const bf16* xrow = X1 + (size_t)m * DM + 8 * kg; const bf16* y0row = Y + (size_t)(2 * m) * DM + 8 * kg; const bf16* y1row = y0row + DM; bf16* orow = X2 + (size_t)m * DM + 8 * kg;
        u32x4 xa[4], ya[4], za[4], xb[4], yb[4], zb[4];
#pragma unroll
        for (int i = 0; i < 4; ++i) { xa[i] = *(const u32x4*)(xrow + 32 * i); ya[i] = *(const u32x4*)(y0row + 32 * i); za[i] = *(const u32x4*)(y1row + 32 * i); }
        float ss = 0.f; f32x4 acc = {0.f, 0.f, 0.f, 0.f};
#pragma unroll
        for (int c = 0; c < 8; ++c) {
            if (c < 7) {
#pragma unroll
                for (int i = 0; i < 4; ++i) { const int sn = 4 * (c + 1) + i; xb[i] = *(const u32x4*)(xrow + 32 * sn); yb[i] = *(const u32x4*)(y0row + 32 * sn); zb[i] = *(const u32x4*)(y1row + 32 * sn); } }
#pragma unroll
            for (int i = 0; i < 4; ++i) { const int sI = 4 * c + i; const u32x4 xw = xa[i], yw = ya[i], zw = za[i];
                const float v0 = bflo(xw.x) + bflo(yw.x) + bflo(zw.x), v1 = bfhi(xw.x) + bfhi(yw.x) + bfhi(zw.x), v2 = bflo(xw.y) + bflo(yw.y) + bflo(zw.y), v3 = bfhi(xw.y) + bfhi(yw.y) + bfhi(zw.y);
                const float v4 = bflo(xw.z) + bflo(yw.z) + bflo(zw.z), v5 = bfhi(xw.z) + bfhi(yw.z) + bfhi(zw.z), v6 = bflo(xw.w) + bflo(yw.w) + bflo(zw.w), v7 = bfhi(xw.w) + bfhi(yw.w) + bfhi(zw.w);
                ss += (v0 * v0 + v1 * v1) + (v2 * v2 + v3 * v3) + (v4 * v4 + v5 * v5) + (v6 * v6 + v7 * v7);
                u32x4 hw; hw.x = pk2(v0, v1); hw.y = pk2(v2, v3); hw.z = pk2(v4, v5); hw.w = pk2(v6, v7);
                *(u32x4*)(orow + 32 * sI) = hw;
                u32x4 lw; lw.x = pk2(v0 - bflo(hw.x), v1 - bfhi(hw.x)); lw.y = pk2(v2 - bflo(hw.y), v3 - bfhi(hw.y)); lw.z = pk2(v4 - bflo(hw.z), v5 - bfhi(hw.z)); lw.w = pk2(v6 - bflo(hw.w), v7 - bfhi(hw.w));
                const bf16x8 ah = *reinterpret_cast<const bf16x8*>(&hw), al = *reinterpret_cast<const bf16x8*>(&lw);
                const bf16x8 bh = *(const LAS bf16x8*)(bhp + 32 * sI), bl = *(const LAS bf16x8*)(bhp + LO + 32 * sI);
                acc = __builtin_amdgcn_mfma_f32_16x16x32_bf16(ah, bh, acc, 0, 0, 0); acc = __builtin_amdgcn_mfma_f32_16x16x32_bf16(al, bh, acc, 0, 0, 0); acc = __builtin_amdgcn_mfma_f32_16x16x32_bf16(ah, bl, acc, 0, 0, 0); }
            __builtin_amdgcn_sched_barrier(0);
#pragma unroll
            for (int i = 0; i < 4; ++i) { xa[i] = xb[i]; ya[i] = yb[i]; za[i] = zb[i]; }
        }
        { auto rr = __builtin_amdgcn_permlane16_swap(__float_as_uint(ss), __float_as_uint(ss), false, false); ss = __uint_as_float(rr[0]) + __uint_as_float(rr[1]); }
        { auto rr = __builtin_amdgcn_permlane32_swap(__float_as_uint(ss), __float_as_uint(ss), false, false); ss = __uint_as_float(rr[0]) + __uint_as_float(rr[1]); }
        const float rstd = __frsqrt_rn(ss * (1.f / DM) + EPS);
        if (kg == 0) { rstd1[m] = rstd; RS[t] = rstd; }
        LDS_WAIT(); asm volatile("" ::: "memory");
        { const float bias = gb[t]; const int type = t >> 2;
#pragma unroll
          for (int r = 0; r < 4; ++r) { float x = acc[r] * RS[4 * kg + r] + bias;
              if (type & 1) x = fminf(x, 0.f) - log1pf(__expf(-fabsf(x)));
              gates[(size_t)(m0 + 4 * kg + r) * 16 + t] = x; } }
        LDS_WAIT(); asm volatile("" ::: "memory");
    }
    __syncthreads();
    moe_convert_items(a, 1, (LAS float*)(lds + wave * 16384), gw, ngw, lane);
}


namespace ml {
using att::f32x16; using att::s16x4; using att::crow; using att::cvtpk; using att::tr_read; using att::v_rd_base;
constexpr int QS = 0, KS = 32768, KT = 65536, VS = 98304, AVS = 114688, CS = 131072, MISC = 147456;
constexpr int M_AL = MISC, M_TH = MISC + 512, M_QN = MISC + 1024, M_N = MISC + 1536, M_NP = MISC + 2048, M_SCR = MISC + 6144;
constexpr size_t WS_QC = WS_HN, WS_KC = WS_HN + 32 * MiB;
constexpr size_t WS_AL = WS_TAPS, WS_TH = WS_TAPS + 1 * MiB, WS_AP = WS_TAPS + 2 * MiB, WS_AM = WS_TAPS + 3 * MiB, WS_BL = WS_TAPS + 4 * MiB;
__device__ __forceinline__ int v_st2(int k, int c) { return ((k >> 3) * 2 + (c >> 5)) * 512 + ((k & 7) * 32 + (c & 31)) * 2; }
__device__ __forceinline__ int v_st4(int k, int c) { return ((k >> 3) * 4 + (c >> 5)) * 512 + ((k & 7) * 32 + (c & 31)) * 2; }
constexpr int rd2(int ks, int half) { return ks * 2048 + half * 1024; }
constexpr int rd4(int ks, int half) { return ks * 4096 + half * 2048; }
#define MLPK(L, H) (bf16x8){L[0], L[1], L[2], L[3], H[0], H[1], H[2], H[3]}
#define ML_WAIT() do { asm volatile("s_waitcnt lgkmcnt(0)" ::: "memory"); __builtin_amdgcn_sched_barrier(0); } while (0)
__device__ __forceinline__ void unpack8(const u32x4 w, float (&v)[8]) { v[0] = bflo(w.x); v[1] = bfhi(w.x); v[2] = bflo(w.y); v[3] = bfhi(w.y); v[4] = bflo(w.z); v[5] = bfhi(w.z); v[6] = bflo(w.w); v[7] = bfhi(w.w); }

__device__ __forceinline__ void mlstm_gate_stats(const DArgs& a, int vcu, int G) {
    const int tid = opaque_tid(), lane = tid & 63, wave = tid >> 6;
    const int gw = vcu * NWAVES + wave, ngw = G * NWAVES;
    const float* gates = (const float*)(a.ws + WS_GATES);
    for (int g = gw; g < 64 * 32; g += ngw) {
        const int sq = g >> 5, j = g & 31, h = sq & 3, dir = (sq >> 2) & 1, b = sq >> 3;
        const float* gb = gates + (size_t)b * SEQ * 16 + (dir * 2) * 4 + h;
        const int t0 = j * 128 + lane, t1 = t0 + 64; const int p0 = dir ? (SEQ - 1 - t0) : t0, p1 = dir ? (SEQ - 1 - t1) : t1;
        const float li0 = gb[(size_t)p0 * 16], lf0 = gb[(size_t)p0 * 16 + 4], li1 = gb[(size_t)p1 * 16], lf1 = gb[(size_t)p1 * 16 + 4];
        float x0 = lf0, x1 = lf1;
#pragma unroll
        for (int o = 1; o < 64; o <<= 1) { const float v0 = __shfl_up(x0, o), v1 = __shfl_up(x1, o); if (lane >= o) { x0 += v0; x1 += v1; } }
        x1 += __shfl(x0, 63);
        float amax = fmaxf(li0 - x0, li1 - x1);
#pragma unroll
        for (int o = 1; o < 64; o <<= 1) amax = fmaxf(amax, __shfl_xor(amax, o));
        if (lane == 63) { ((float*)(a.ws + WS_AM))[g] = amax; ((float*)(a.ws + WS_BL))[g] = x1; }
    }
}

__device__ __forceinline__ void phase_mlstm_pre(const DArgs& a, int vcu, int G) {
    const int tid = opaque_tid(), lane = tid & 63, wave = tid >> 6;
    const int gw = vcu * NWAVES + wave, ngw = G * NWAVES;
    const bf16* U = (const bf16*)(a.ws + WS_U); const float* gates = (const float*)(a.ws + WS_GATES);
    const float* cw = a.in<22>(); const float* cb = a.in<23>();
    for (int g = gw; g < 64 * 32; g += ngw) {
        const int sq = g >> 5, j = g & 31, h = sq & 3, dir = (sq >> 2) & 1, b = sq >> 3;
        const float* gb = gates + (size_t)b * SEQ * 16 + (dir * 2) * 4 + h;
        const float* AM = (const float*)(a.ws + WS_AM) + sq * 32; const float* BL = (const float*)(a.ws + WS_BL) + sq * 32;
        const float am = AM[lane & 31], bl = BL[lane & 31];
        float m = 0.f, Mc = 0.f, ap = 0.f;
        for (int jj = 0; jj < 32; ++jj) { const float amj = __shfl(am, jj), blj = __shfl(bl, jj); const float M2 = fmaxf(m, amj);
            if (jj == j) { Mc = M2; ap = __expf(m - M2); } m = blj + M2; }
        const int t0 = j * 128 + lane, t1 = t0 + 64; const int p0 = dir ? (SEQ - 1 - t0) : t0, p1 = dir ? (SEQ - 1 - t1) : t1;
        const float li0 = gb[(size_t)p0 * 16], lf0 = gb[(size_t)p0 * 16 + 4], li1 = gb[(size_t)p1 * 16], lf1 = gb[(size_t)p1 * 16 + 4];
        float x0 = lf0, x1 = lf1;
#pragma unroll
        for (int o = 1; o < 64; o <<= 1) { const float v0 = __shfl_up(x0, o), v1 = __shfl_up(x1, o); if (lane >= o) { x0 += v0; x1 += v1; } }
        x1 += __shfl(x0, 63);
        float* AL = (float*)(a.ws + WS_AL) + (size_t)sq * SEQ; float* TH = (float*)(a.ws + WS_TH) + (size_t)sq * SEQ; float* AP = (float*)(a.ws + WS_AP) + sq * 32;
        AL[t0] = __expf(li0 - x0 - Mc); AL[t1] = __expf(li1 - x1 - Mc); TH[t0] = __expf(-x0 - Mc); TH[t1] = __expf(-x1 - Mc);
        if (lane == 0) AP[j] = ap;
    }
    bf16* QC = (bf16*)(a.ws + WS_QC); bf16* KC = (bf16*)(a.ws + WS_KC);
    float wq[3][8], wk[3][8], bq[8], bk[8];
#pragma unroll
    for (int j = 0; j < 8; ++j) { bq[j] = cb[8 * lane + j]; bk[j] = cb[512 + 8 * lane + j];
#pragma unroll
        for (int t = 0; t < 3; ++t) { wq[t][j] = cw[t * 1024 + 8 * lane + j]; wk[t][j] = cw[t * 1024 + 512 + 8 * lane + j]; } }
    const int hq = lane >> 4, dq = 8 * (lane & 15);
    for (int g = gw; g < NTOK / 8; g += ngw) {
        const int m0 = g * 8, b = m0 >> 12, s0 = m0 & (SEQ - 1);
        const bf16* base = U + (size_t)m0 * NU + 8 * lane;
        u32x4 qw[10], kw[10];
#pragma unroll
        for (int r = 0; r < 10; ++r) { const int s = s0 + r - 1;
            if (s >= 0 && s < SEQ) { qw[r] = *(const u32x4*)(base + (long)(r - 1) * NU); kw[r] = *(const u32x4*)(base + (long)(r - 1) * NU + 512); }
            else { qw[r] = (u32x4){0u, 0u, 0u, 0u}; kw[r] = qw[r]; } }
#pragma unroll
        for (int r = 0; r < 8; ++r) {
            const int s = s0 + r;
            float x0[8], x1[8], x2[8], oq[8], ok[8];
            unpack8(qw[r], x0); unpack8(qw[r + 1], x1); unpack8(qw[r + 2], x2);
#pragma unroll
            for (int j = 0; j < 8; ++j) oq[j] = siluf_(bq[j] + x0[j] * wq[0][j] + x1[j] * wq[1][j] + x2[j] * wq[2][j]) * 0.08838834764831845f;
            unpack8(kw[r], x0); unpack8(kw[r + 1], x1); unpack8(kw[r + 2], x2);
#pragma unroll
            for (int j = 0; j < 8; ++j) ok[j] = siluf_(bk[j] + x0[j] * wk[0][j] + x1[j] * wk[1][j] + x2[j] * wk[2][j]);
            u32x4 w; w.x = pk2(oq[0], oq[1]); w.y = pk2(oq[2], oq[3]); w.z = pk2(oq[4], oq[5]); w.w = pk2(oq[6], oq[7]);
            *(u32x4*)(QC + ((size_t)((b * 4 + hq) * SEQ + s)) * 128 + dq) = w;
            w.x = pk2(ok[0], ok[1]); w.y = pk2(ok[2], ok[3]); w.z = pk2(ok[4], ok[5]); w.w = pk2(ok[6], ok[7]);
            *(u32x4*)(KC + ((size_t)((b * 4 + hq) * SEQ + s)) * 128 + dq) = w;
        }
    }
}

__device__ __forceinline__ void phase_mlstm(const DArgs& a, LAS unsigned char* lds, int ldsb, int vcu, int G) {
    const int tid = opaque_tid(), wid = __builtin_amdgcn_readfirstlane(tid >> 6), lane = tid & 63, r32 = lane & 31, hi = lane >> 5;
    const int eh = wid >> 2, tb = eh ? 3 - (wid & 3) : (wid & 3), oi = wid & 3;
    const bool owner = tb <= 1;
    const bf16* U = (const bf16*)(a.ws + WS_U); const bf16* QC = (const bf16*)(a.ws + WS_QC); const bf16* KC = (const bf16*)(a.ws + WS_KC);
    LAS float* ALl = (LAS float*)(lds + M_AL); LAS float* THl = (LAS float*)(lds + M_TH); LAS float* QN = (LAS float*)(lds + M_QN); LAS float* NS = (LAS float*)(lds + M_N);
    LAS float* NP = (LAS float*)(lds + M_NP); LAS float* SCR = (LAS float*)(lds + M_SCR) + wid * 64;
    const int vbase = ldsb + v_rd_base(lane);
    const int vbC = vbase + CS + eh * 512, vbVe = vbase + VS + eh * 512, vbAV = vbase + VS, vbKT = vbase + KT + oi * 512;
    const int cvec = tid & 15, rowb = tid >> 4, vvec = tid & 7, vrow = tid >> 3;
    LAS unsigned char* cwb = lds + CS + (oi >> 1) * 8192 + (oi & 1) * 4096 + hi * 1024 + r32 * 2;
    for (int it = vcu; it < 256; it += G) {
        const int slice = it & 3, h = (it >> 2) & 3, dir = (it >> 4) & 1, b = it >> 5, sq = (b * 2 + dir) * 4 + h;
        for (int i = tid; i < 4096; i += NTHR) ((LAS unsigned*)(lds + CS))[i] = 0u;
        if (tid < 128) NS[tid] = 0.f;
        f32x16 Cacc0 = f32x16{}, Cacc1 = f32x16{};
        const bf16* qb = QC + (size_t)(b * 4 + h) * SEQ * 128; const bf16* kb = KC + (size_t)(b * 4 + h) * SEQ * 128;
        const bf16* vb = U + (size_t)b * SEQ * NU + 1024 + h * 256 + slice * 64;
        const float* AL = (const float*)(a.ws + WS_AL) + (size_t)sq * SEQ; const float* TH = (const float*)(a.ws + WS_TH) + (size_t)sq * SEQ; const float* AP = (const float*)(a.ws + WS_AP) + sq * 32;
        u32x4 rq[4], rk[4], rv[2]; float ralk[4], r_th = 0.f, r_ap;
#define ML_PREFETCH(CH) do { \
            _Pragma("unroll") for (int i = 0; i < 4; ++i) { const int tt = (CH) * 128 + rowb + 32 * i, p = dir ? (SEQ - 1 - tt) : tt; rq[i] = *(const u32x4*)(qb + (unsigned)(p * 128 + 8 * cvec)); rk[i] = *(const u32x4*)(kb + (unsigned)(p * 128 + 8 * cvec)); ralk[i] = AL[tt]; } \
            _Pragma("unroll") for (int i = 0; i < 2; ++i) { const int tt = (CH) * 128 + vrow + 64 * i, p = dir ? (SEQ - 1 - tt) : tt; rv[i] = *(const u32x4*)(vb + (unsigned)(p * NU + 8 * vvec)); } \
            if (tid < 128) { r_th = TH[(CH) * 128 + tid]; } r_ap = AP[(CH)]; } while (0)
        ML_PREFETCH(0);
        __syncthreads();
        for (int ch = 0; ch < SEQ / 128; ++ch) {
            const float a_prev = __builtin_bit_cast(float, __builtin_amdgcn_readfirstlane(__builtin_bit_cast(int, r_ap)));
            { float cs[8];
#pragma unroll
              for (int j = 0; j < 8; ++j) cs[j] = 0.f;
#pragma unroll
              for (int i = 0; i < 4; ++i) { const int t = rowb + 32 * i; const int ro = t * 256 + ((cvec * 16) ^ ((t & 7) << 4));
                  *(LAS u32x4*)(lds + QS + ro) = rq[i];
                  float kv[8]; unpack8(rk[i], kv); const float al = ralk[i];
#pragma unroll
                  for (int j = 0; j < 8; ++j) { kv[j] *= al; cs[j] += kv[j]; }
                  u32x4 w; w.x = pk2(kv[0], kv[1]); w.y = pk2(kv[2], kv[3]); w.z = pk2(kv[4], kv[5]); w.w = pk2(kv[6], kv[7]);
                  *(LAS u32x4*)(lds + KS + ro) = w; *(LAS u32x4*)(lds + KT + (t >> 6) * 16384 + v_st4(t & 63, 8 * cvec)) = w; }
#pragma unroll
              for (int j = 0; j < 8; ++j) {
                  { auto rr = __builtin_amdgcn_permlane16_swap(__float_as_uint(cs[j]), __float_as_uint(cs[j]), false, false); cs[j] = __uint_as_float(rr[0]) + __uint_as_float(rr[1]); }
                  { auto rr = __builtin_amdgcn_permlane32_swap(__float_as_uint(cs[j]), __float_as_uint(cs[j]), false, false); cs[j] = __uint_as_float(rr[0]) + __uint_as_float(rr[1]); } }
              if (lane < 16) { *(LAS f32x4*)(NP + wid * 128 + cvec * 8) = (f32x4){cs[0], cs[1], cs[2], cs[3]}; *(LAS f32x4*)(NP + wid * 128 + cvec * 8 + 4) = (f32x4){cs[4], cs[5], cs[6], cs[7]}; } }
#pragma unroll
            for (int i = 0; i < 2; ++i) { const int t = vrow + 64 * i; *(LAS u32x4*)(lds + VS + (t >> 6) * 8192 + v_st2(t & 63, 8 * vvec)) = rv[i]; }
            if (tid < 128) { THl[tid] = r_th; }
            __syncthreads();
            if (ch + 1 < SEQ / 128) ML_PREFETCH(ch + 1);
            s16x4 cl[8], chh[8];
#define ML_CRD(T, KS) do { cl[4 * (T) + (KS)] = tr_read<(T) * 8192 + rd2((KS), 0)>(vbC); chh[4 * (T) + (KS)] = tr_read<(T) * 8192 + rd2((KS), 1)>(vbC); } while (0)
            ML_CRD(0, 0); ML_CRD(0, 1); ML_CRD(0, 2); ML_CRD(0, 3); ML_CRD(1, 0); ML_CRD(1, 1); ML_CRD(1, 2); ML_CRD(1, 3);
#undef ML_CRD
            { const int t = tid >> 2, part = tid & 3; f32x2 d2 = {0.f, 0.f};
#pragma unroll
              for (int i = 0; i < 4; ++i) { const int c16 = part * 4 + i; float qv[8]; unpack8(*(const LAS u32x4*)(lds + QS + t * 256 + ((c16 * 16) ^ ((t & 7) << 4))), qv);
                  const f32x4 n0 = *(const LAS f32x4*)(NS + c16 * 8), n1 = *(const LAS f32x4*)(NS + c16 * 8 + 4);
                  d2 += (f32x2){qv[0], qv[1]} * (f32x2){n0.x, n0.y}; d2 += (f32x2){qv[2], qv[3]} * (f32x2){n0.z, n0.w}; d2 += (f32x2){qv[4], qv[5]} * (f32x2){n1.x, n1.y}; d2 += (f32x2){qv[6], qv[7]} * (f32x2){n1.z, n1.w}; }
              float d = quad_sum(d2.x + d2.y);
              if (part == 0) QN[t] = d;
            }
            bf16x8 qr[8];
            { const int row = 32 * tb + r32;
#pragma unroll
              for (int d0 = 0; d0 < 8; ++d0) qr[d0] = *(const LAS bf16x8*)(lds + QS + row * 256 + ((d0 * 32 + hi * 16) ^ ((row & 7) << 4))); }
            f32x16 o = f32x16{};
            ML_WAIT();
#pragma unroll
            for (int k8 = 0; k8 < 8; ++k8) o = __builtin_amdgcn_mfma_f32_32x32x16_bf16(qr[k8], MLPK(cl[k8], chh[k8]), o, 0, 0, 0);
#pragma unroll
            for (int r = 0; r < 16; ++r) o[r] *= a_prev;
            float ps = 0.f, ps2 = 0.f; f32x16 pA; s16x4 vr0, vr1, vr2, vr3; bf16x8 pa0, pa1;
#define ML_SP(SB, P) do { P = f32x16{}; const int rowk = 32 * (SB) + r32; \
              _Pragma("unroll") for (int d0 = 0; d0 < 8; ++d0) { const bf16x8 ka = *(const LAS bf16x8*)(lds + KS + rowk * 256 + ((d0 * 32 + hi * 16) ^ ((rowk & 7) << 4))); \
                  P = __builtin_amdgcn_mfma_f32_32x32x16_bf16(ka, qr[d0], P, 0, 0, 0); } } while (0)
#define ML_VRD(SB) do { vr0 = tr_read<((SB) >> 1) * 8192 + rd2(((SB) & 1) * 2, 0)>(vbVe); vr1 = tr_read<((SB) >> 1) * 8192 + rd2(((SB) & 1) * 2, 1)>(vbVe); \
              vr2 = tr_read<((SB) >> 1) * 8192 + rd2(((SB) & 1) * 2 + 1, 0)>(vbVe); vr3 = tr_read<((SB) >> 1) * 8192 + rd2(((SB) & 1) * 2 + 1, 1)>(vbVe); } while (0)
#define ML_PFIN(SB, P) do { if ((SB) == tb) { _Pragma("unroll") for (int r = 0; r < 16; ++r) if (crow(r, hi) > r32) P[r] = 0.f; } \
              { u32x4 w = {cvtpk(P[0], P[1]), cvtpk(P[2], P[3]), cvtpk(P[4], P[5]), cvtpk(P[6], P[7])}; pa0 = *reinterpret_cast<bf16x8*>(&w); \
                ps = att::dot_ones(w.x, ps); ps2 = att::dot_ones(w.y, ps2); ps = att::dot_ones(w.z, ps); ps2 = att::dot_ones(w.w, ps2); } \
              { u32x4 w = {cvtpk(P[8], P[9]), cvtpk(P[10], P[11]), cvtpk(P[12], P[13]), cvtpk(P[14], P[15])}; pa1 = *reinterpret_cast<bf16x8*>(&w); \
                ps = att::dot_ones(w.x, ps); ps2 = att::dot_ones(w.y, ps2); ps = att::dot_ones(w.z, ps); ps2 = att::dot_ones(w.w, ps2); } } while (0)
#define ML_PVM() do { o = __builtin_amdgcn_mfma_f32_32x32x16_bf16(pa0, MLPK(vr0, vr1), o, 0, 0, 0); o = __builtin_amdgcn_mfma_f32_32x32x16_bf16(pa1, MLPK(vr2, vr3), o, 0, 0, 0); } while (0)
            ML_SP(0, pA); ML_VRD(0); ML_PFIN(0, pA); ML_WAIT(); ML_PVM();
            if (tb >= 1) { ML_SP(1, pA); ML_VRD(1); ML_PFIN(1, pA); ML_WAIT(); ML_PVM();
                if (tb >= 2) { ML_SP(2, pA); ML_VRD(2); ML_PFIN(2, pA); ML_WAIT(); ML_PVM();
                    if (tb >= 3) { ML_SP(3, pA); ML_VRD(3); ML_PFIN(3, pA); ML_WAIT(); ML_PVM(); } } }
#undef ML_SP
#undef ML_VRD
#undef ML_PFIN
#undef ML_PVM
            ps += ps2;
            { auto rr = __builtin_amdgcn_permlane32_swap(__float_as_uint(ps), __float_as_uint(ps), false, false); ps = __uint_as_float(rr[0]) + __uint_as_float(rr[1]); }
            if (owner) {
#pragma unroll
                for (int r = 0; r < 16; ++r) { Cacc0[r] *= a_prev; Cacc1[r] *= a_prev; }
#define ML_ST(T) do { const s16x4 al_0 = tr_read<(T) * 16384 + rd4(0, 0)>(vbKT), ah_0 = tr_read<(T) * 16384 + rd4(0, 1)>(vbKT), al_1 = tr_read<(T) * 16384 + rd4(1, 0)>(vbKT), ah_1 = tr_read<(T) * 16384 + rd4(1, 1)>(vbKT); \
              const s16x4 al_2 = tr_read<(T) * 16384 + rd4(2, 0)>(vbKT), ah_2 = tr_read<(T) * 16384 + rd4(2, 1)>(vbKT), al_3 = tr_read<(T) * 16384 + rd4(3, 0)>(vbKT), ah_3 = tr_read<(T) * 16384 + rd4(3, 1)>(vbKT); \
              const s16x4 bl_0 = tr_read<(T) * 8192 + rd2(0, 0)>(vbAV), bh_0 = tr_read<(T) * 8192 + rd2(0, 1)>(vbAV), bl_1 = tr_read<(T) * 8192 + rd2(1, 0)>(vbAV), bh_1 = tr_read<(T) * 8192 + rd2(1, 1)>(vbAV); \
              const s16x4 bl_2 = tr_read<(T) * 8192 + rd2(2, 0)>(vbAV), bh_2 = tr_read<(T) * 8192 + rd2(2, 1)>(vbAV), bl_3 = tr_read<(T) * 8192 + rd2(3, 0)>(vbAV), bh_3 = tr_read<(T) * 8192 + rd2(3, 1)>(vbAV); \
              const s16x4 cl_0 = tr_read<(T) * 8192 + 512 + rd2(0, 0)>(vbAV), ch_0 = tr_read<(T) * 8192 + 512 + rd2(0, 1)>(vbAV), cl_1 = tr_read<(T) * 8192 + 512 + rd2(1, 0)>(vbAV), ch_1 = tr_read<(T) * 8192 + 512 + rd2(1, 1)>(vbAV); \
              const s16x4 cl_2 = tr_read<(T) * 8192 + 512 + rd2(2, 0)>(vbAV), ch_2 = tr_read<(T) * 8192 + 512 + rd2(2, 1)>(vbAV), cl_3 = tr_read<(T) * 8192 + 512 + rd2(3, 0)>(vbAV), ch_3 = tr_read<(T) * 8192 + 512 + rd2(3, 1)>(vbAV); \
              ML_WAIT(); \
              Cacc0 = __builtin_amdgcn_mfma_f32_32x32x16_bf16(MLPK(al_0, ah_0), MLPK(bl_0, bh_0), Cacc0, 0, 0, 0); Cacc1 = __builtin_amdgcn_mfma_f32_32x32x16_bf16(MLPK(al_0, ah_0), MLPK(cl_0, ch_0), Cacc1, 0, 0, 0); \
              Cacc0 = __builtin_amdgcn_mfma_f32_32x32x16_bf16(MLPK(al_1, ah_1), MLPK(bl_1, bh_1), Cacc0, 0, 0, 0); Cacc1 = __builtin_amdgcn_mfma_f32_32x32x16_bf16(MLPK(al_1, ah_1), MLPK(cl_1, ch_1), Cacc1, 0, 0, 0); \
              Cacc0 = __builtin_amdgcn_mfma_f32_32x32x16_bf16(MLPK(al_2, ah_2), MLPK(bl_2, bh_2), Cacc0, 0, 0, 0); Cacc1 = __builtin_amdgcn_mfma_f32_32x32x16_bf16(MLPK(al_2, ah_2), MLPK(cl_2, ch_2), Cacc1, 0, 0, 0); \
              Cacc0 = __builtin_amdgcn_mfma_f32_32x32x16_bf16(MLPK(al_3, ah_3), MLPK(bl_3, bh_3), Cacc0, 0, 0, 0); Cacc1 = __builtin_amdgcn_mfma_f32_32x32x16_bf16(MLPK(al_3, ah_3), MLPK(cl_3, ch_3), Cacc1, 0, 0, 0); } while (0)
                ML_ST(0); ML_ST(1);
#undef ML_ST
            }
            __syncthreads();
            { const float D = a_prev * QN[32 * tb + r32] + ps; const float dinv = __builtin_amdgcn_rcpf(fmaxf(fabsf(D), THl[32 * tb + r32]));
              if (hi == 0) SCR[r32] = dinv; asm volatile("s_waitcnt lgkmcnt(0)" ::: "memory");
              bf16* H = (bf16*)(a.ws + (dir ? WS_HB : WS_HF)) + (size_t)b * SEQ * DM + h * 256 + slice * 64 + eh * 32 + r32;
#pragma unroll
              for (int r = 0; r < 16; ++r) { const int t = ch * 128 + 32 * tb + crow(r, hi), p = dir ? (SEQ - 1 - t) : t; H[(size_t)p * DM] = (bf16)(pk2(o[r] * SCR[crow(r, hi)], 0.f) & 0xffffu); } }
            if (owner) {
#pragma unroll
                for (int r = 0; r < 16; r += 2) { const unsigned w0 = pk2(Cacc0[r], Cacc0[r + 1]), w1 = pk2(Cacc1[r], Cacc1[r + 1]);
                    LAS unsigned char* c0 = cwb + ((r >> 3) & 1) * 2048 + ((r & 3) + 4 * ((r >> 2) & 1)) * 64; LAS unsigned char* c1 = cwb + (((r + 1) >> 3) & 1) * 2048 + (((r + 1) & 3) + 4 * (((r + 1) >> 2) & 1)) * 64;
                    *(LAS bf16*)c0 = (bf16)(w0 & 0xffffu); *(LAS bf16*)c1 = (bf16)(w0 >> 16); *(LAS bf16*)(c0 + 512) = (bf16)(w1 & 0xffffu); *(LAS bf16*)(c1 + 512) = (bf16)(w1 >> 16); } }
            if (tid < 128) NS[tid] = a_prev * NS[tid] + (((NP[tid] + NP[128 + tid]) + (NP[256 + tid] + NP[384 + tid])) + ((NP[512 + tid] + NP[640 + tid]) + (NP[768 + tid] + NP[896 + tid])));
            __syncthreads();
        }
#undef ML_PREFETCH
    }
}
#undef MLPK
#undef ML_WAIT
}

__device__ __forceinline__ void phase_post_mix1(const DArgs& a, int vcu, int G) {
    const int tid = opaque_tid(), lane = tid & 63, wave = tid >> 6;
    const int gw = vcu * NWAVES + wave, ngw = G * NWAVES;
    const bf16* Hf = (const bf16*)(a.ws + WS_HF); const bf16* Hb = (const bf16*)(a.ws + WS_HB); const bf16* U = (const bf16*)(a.ws + WS_U);
    const float* on = a.in<25>(); bf16* A2 = (bf16*)(a.ws + WS_HN);
    float onr[16];
#pragma unroll
    for (int i = 0; i < 16; ++i) onr[i] = on[16 * lane + i];
    u32x4 nf[2], nb[2], no[2];
#pragma unroll
    for (int half = 0; half < 2; ++half) { const int col = 16 * lane + 8 * half; if (gw < NTOK) {
        nf[half] = *(const u32x4*)(Hf + (size_t)gw * DM + col); nb[half] = *(const u32x4*)(Hb + (size_t)gw * DM + col); no[half] = *(const u32x4*)(U + (size_t)gw * NU + 2048 + col); } }
    for (int m = gw; m < NTOK; m += ngw) {
        float v[16], o[16];
        u32x4 cf[2] = {nf[0], nf[1]}, cb[2] = {nb[0], nb[1]}, co[2] = {no[0], no[1]};
        if (m + ngw < NTOK) { const size_t mn = (size_t)(m + ngw);
#pragma unroll
            for (int half = 0; half < 2; ++half) { const int col = 16 * lane + 8 * half;
                nf[half] = *(const u32x4*)(Hf + mn * DM + col); nb[half] = *(const u32x4*)(Hb + mn * DM + col); no[half] = *(const u32x4*)(U + mn * NU + 2048 + col); } }
#pragma unroll
        for (int half = 0; half < 2; ++half) {
            const u32x4 f = cf[half], bk = cb[half], ow = co[half];
            v[8 * half + 0] = bflo(f.x) + bflo(bk.x); v[8 * half + 1] = bfhi(f.x) + bfhi(bk.x); v[8 * half + 2] = bflo(f.y) + bflo(bk.y); v[8 * half + 3] = bfhi(f.y) + bfhi(bk.y);
            v[8 * half + 4] = bflo(f.z) + bflo(bk.z); v[8 * half + 5] = bfhi(f.z) + bfhi(bk.z); v[8 * half + 6] = bflo(f.w) + bflo(bk.w); v[8 * half + 7] = bfhi(f.w) + bfhi(bk.w);
            o[8 * half + 0] = bflo(ow.x); o[8 * half + 1] = bfhi(ow.x); o[8 * half + 2] = bflo(ow.y); o[8 * half + 3] = bfhi(ow.y);
            o[8 * half + 4] = bflo(ow.z); o[8 * half + 5] = bfhi(ow.z); o[8 * half + 6] = bflo(ow.w); o[8 * half + 7] = bfhi(ow.w); }
        float ss = 0.f;
#pragma unroll
        for (int i = 0; i < 16; ++i) ss += v[i] * v[i];
        ss = row16_sum(ss);
        const float rstd = __frsqrt_rn(ss * (1.f / 256.f) + EPS);
        float r[16];
#pragma unroll
        for (int i = 0; i < 16; ++i) r[i] = v[i] * rstd * onr[i] * sigmoidf_(o[i]);
        u32x4 w0, w1; w0.x = pk2(r[0], r[1]); w0.y = pk2(r[2], r[3]); w0.z = pk2(r[4], r[5]); w0.w = pk2(r[6], r[7]);
        w1.x = pk2(r[8], r[9]); w1.y = pk2(r[10], r[11]); w1.z = pk2(r[12], r[13]); w1.w = pk2(r[14], r[15]);
        *(u32x4*)(A2 + (size_t)m * DM + 16 * lane) = w0; *(u32x4*)(A2 + (size_t)m * DM + 16 * lane + 8) = w1;
    }
}

#define XB_TMO      128
#define XB_XCNT(j)  (256  + 64 * (j))
#define XB_XSUB(j)  (1280 + 64 * (j))
#define XB_XGEN(j)  (2304 + 64 * (j))
#define XB_TOP      3328
#define XB_TOPGEN   3392
#define XCD_BAR_WORDS 3456
#define XB_SPIN_CAP (1u << 22)
constexpr int CW_BAR = 4096;
constexpr int LDS_CTL_OFF = LDS_BYTES - 256;
__device__ __forceinline__ unsigned xb_ld(unsigned* p)              { return __hip_atomic_load(p, __ATOMIC_RELAXED, __HIP_MEMORY_SCOPE_AGENT); }
__device__ __forceinline__ unsigned xb_add(unsigned* p, unsigned v) { return __hip_atomic_fetch_add(p, v, __ATOMIC_RELAXED, __HIP_MEMORY_SCOPE_AGENT); }
__device__ __forceinline__ unsigned xb_xcc_id() { return (unsigned)__builtin_amdgcn_s_getreg((3 << 11) | 20) & 0xFu; }
#define XB_SPIN(cond, bar) do { unsigned _sp = 0; while (cond) { __builtin_amdgcn_s_sleep(1); \
    if ((++_sp & 255u) == 0u) { if (xb_ld(&(bar)[XB_TMO])) break; if (_sp > XB_SPIN_CAP) { atomicAdd(&(bar)[XB_TMO], 1u); break; } } } } while (0)
struct XcdBarrier { unsigned* bar; unsigned x; volatile LAS unsigned* st; };
__device__ __forceinline__ XcdBarrier xcd_barrier_post(unsigned* bar, volatile LAS unsigned* st) {
    XcdBarrier b; b.bar = bar; b.x = xb_xcc_id(); b.st = st;
    if (threadIdx.x == 0) (void)xb_add(&bar[XB_XCNT(b.x)], 1u);
    return b;
}
__device__ __forceinline__ void xcd_barrier_complete(unsigned* bar, unsigned x, unsigned& nloc, unsigned& nx) {
    const unsigned G = gridDim.x * gridDim.y * gridDim.z;
    unsigned sum, cnt, mine, sp = 0u;
    for (;;) {
        sum = 0u; cnt = 0u; mine = 0u;
#pragma unroll
        for (unsigned j = 0; j < 16; ++j) { const unsigned c = xb_ld(&bar[XB_XCNT(j)]); sum += c; cnt += (c > 0u) ? 1u : 0u; mine = (j == x) ? c : mine; }
        if (sum == G) break;
        __builtin_amdgcn_s_sleep(1);
        if ((++sp & 255u) == 0u) { if (xb_ld(&bar[XB_TMO])) break; if (sp > XB_SPIN_CAP) { atomicAdd(&bar[XB_TMO], 1u); break; } }
    }
    nloc = mine > 0u ? mine : 1u; nx = cnt > 0u ? cnt : 1u;
}
__device__ __forceinline__ void xcd_barrier(const XcdBarrier& b) {
    asm volatile("s_waitcnt vmcnt(0)" ::: "memory");
    __syncthreads();
    if (threadIdx.x == 0) {
        unsigned* bar = b.bar;
        __builtin_amdgcn_s_waitcnt(0);
        unsigned nloc = b.st[0], nx = b.st[1];
        if (nloc == 0u) { xcd_barrier_complete(bar, b.x, nloc, nx); b.st[0] = nloc; b.st[1] = nx; }
        const unsigned old = xb_add(&bar[XB_XSUB(b.x)], 1u);
        const unsigned gen = old / nloc;
        if (old + 1u == (gen + 1u) * nloc) {
            __builtin_amdgcn_fence(__ATOMIC_RELEASE, "agent");
            asm volatile("s_waitcnt vmcnt(0)" ::: "memory");
            const unsigned og = xb_add(&bar[XB_TOP], 1u);
            const unsigned tg = og / nx;
            if (og + 1u == (tg + 1u) * nx) xb_add(&bar[XB_TOPGEN], 1u);
            else XB_SPIN(xb_ld(&bar[XB_TOPGEN]) == tg, bar);
            __builtin_amdgcn_fence(__ATOMIC_ACQUIRE, "agent");
            xb_add(&bar[XB_XGEN(b.x)], 1u);
            asm volatile("s_waitcnt vmcnt(0)" ::: "memory");
        } else {
            XB_SPIN(xb_ld(&bar[XB_XGEN(b.x)]) == gen, bar);
            __builtin_amdgcn_fence(__ATOMIC_ACQUIRE, "agent");
            asm volatile("s_waitcnt vmcnt(0)" ::: "memory");
        }
    }
    __syncthreads();
}

__global__ void __launch_bounds__(NTHR, 2) fwd_kernel(Args kargs) {
    extern __shared__ __attribute__((aligned(16))) unsigned char lds_raw[];
    DArgs args; args.ka = (const char*)__builtin_amdgcn_kernarg_segment_ptr(); args.out = kargs.out; args.ws = kargs.ws;
    LAS unsigned char* lds = (LAS unsigned char*)lds_raw;
    const int G = gridDim.x, bx = blockIdx.x;
    const int vcu = (G % 8 == 0) ? (bx % 8) * (G / 8) + bx / 8 : bx;
    const int lo = kargs.ph_lo, hi = kargs.ph_hi;
    unsigned char* ws = args.ws;
#define IN(k) (lo <= (k) && (k) < hi)
#if MK_ONE
    { volatile LAS unsigned* st = (volatile LAS unsigned*)(lds + LDS_CTL_OFF); if (threadIdx.x < 64) st[threadIdx.x] = 0u; }
    __syncthreads();
    XcdBarrier xbar = xcd_barrier_post((unsigned*)(ws + WS_CTL) + CW_BAR, (volatile LAS unsigned*)(lds + LDS_CTL_OFF));
#define SEAM(k) do { if ((k) + 1 < hi) xcd_barrier(xbar); } while (0)
#else
#define SEAM(k) do { __syncthreads(); } while (0)
#endif
    if (IN(0)) { phase_prep0(args, lds, vcu, G); SEAM(0); }
    if (IN(1)) { hyena_taps(args, lds, vcu, G);
        pg8::DenseSched S; S.init((const bf16*)(ws + WS_HN), (const bf16*)(ws + WS_WIN0), NTOK, NU, DM, G, bx);
        pg8::EpiQKV0 E{(bf16*)(ws + WS_U), NU, args.in<4>(), args.in<5>(), (const float*)(ws + WS_ROPE), (const float*)(ws + WS_ROPE) + SEQ * 8};
        pg8::gemm_phase<pg8::EpiQKV0, pg8::DenseSched, false>(lds, DM, S, E); SEAM(1); }
    if (IN(2)) { phase_prep_mix0(args, lds, vcu, G); phase_hyena_kf(args, lds, vcu, G); SEAM(2); }
    if (IN(3)) { phase_attn(args, (char*)lds_raw, vcu, G); phase_hyena_fft(args, lds, vcu, G); SEAM(3); }
    if (IN(4)) { phase_post_mix0(args, lds, vcu, G); SEAM(4); }
    if (IN(5)) { pg8::DenseSched S; S.init((const bf16*)(ws + WS_HN), (const bf16*)(ws + WS_WOUT0), NTOK, DM, DM, G, bx, (unsigned*)(ws + WS_CTL) + CW_OPT0);
        pg8::EpiResBf16<true> E{(const void*)args.in<0>(), (bf16*)(ws + WS_XB), DM};
        pg8::gemm_phase<pg8::EpiResBf16<true>, pg8::DenseSched, false>(lds, DM, S, E); }
    if (IN(6)) { phase_router(args, lds, 0, vcu, G); SEAM(6); }
    if (IN(7)) { phase_moe_gemm(args, lds, 0, 0, G); }
    if (IN(8)) { phase_moe_gemm(args, lds, 0, 1, G); SEAM(8); }
    if (IN(9)) { phase_prep1(args, lds, vcu, G); SEAM(9); }
    if (IN(10)) { ml::mlstm_gate_stats(args, vcu, G); pg8::DenseSched S; S.init((const bf16*)args.out, (const bf16*)(ws + WS_WIN1), NTOK, NU, DM, G, bx);
        pg8::EpiBf16RowScale E{(bf16*)(ws + WS_U), NU, (const float*)(ws + WS_RSTD1)};
        pg8::gemm_phase<pg8::EpiBf16RowScale, pg8::DenseSched, false>(lds, DM, S, E); SEAM(10); }
    if (IN(11)) { ml::phase_mlstm_pre(args, vcu, G); xcd_barrier(xbar); ml::phase_mlstm(args, lds, (int)(uintptr_t)lds_raw, vcu, G); SEAM(11); }
    if (IN(12)) { phase_post_mix1(args, vcu, G); SEAM(12); }
    if (IN(13)) { pg8::DenseSched S; S.init((const bf16*)(ws + WS_HN), (const bf16*)(ws + WS_WOUT1), NTOK, DM, DM, G, bx, (unsigned*)(ws + WS_CTL) + CW_OPT1);
        pg8::EpiResBf16<false> E{(const void*)args.out, (bf16*)(ws + WS_XB), DM};
        pg8::gemm_phase<pg8::EpiResBf16<false>, pg8::DenseSched, false>(lds, DM, S, E); }
    if (IN(14)) { phase_router(args, lds, 1, vcu, G); SEAM(14); }
    if (IN(15)) { phase_moe_gemm(args, lds, 1, 0, G); }
    if (IN(16)) { phase_moe_gemm(args, lds, 1, 1, G); SEAM(16); }
    if (IN(17)) { const int tid17 = opaque_tid(), lane = tid17 & 63, gw = vcu * NWAVES + (tid17 >> 6), ngw = G * NWAVES;
        const bf16* X3 = (const bf16*)(ws + WS_XB); const bf16* Y = (const bf16*)(ws + WS_Y);
        u32x2 xw[4], y0[4], y1[4];
        load_row_bf16(X3 + (size_t)gw * DM, lane, xw); load_row_bf16(Y + (size_t)(2 * gw) * DM, lane, y0); load_row_bf16(Y + (size_t)(2 * gw + 1) * DM, lane, y1);
        for (int m = gw; m < NTOK; m += ngw) { f32x4 v[4];
#pragma unroll
            for (int j = 0; j < 4; ++j) v[j] = (f32x4){bflo(xw[j].x), bfhi(xw[j].x), bflo(xw[j].y), bfhi(xw[j].y)};
            add_row_bf16(v, y0); add_row_bf16(v, y1);
            if (m + ngw < NTOK) { const size_t mn = (size_t)(m + ngw); load_row_bf16(X3 + mn * DM, lane, xw); load_row_bf16(Y + 2 * mn * DM, lane, y0); load_row_bf16(Y + (2 * mn + 1) * DM, lane, y1); }
#pragma unroll
            for (int j = 0; j < 4; ++j) *(f32x4*)(args.out + (size_t)m * DM + 4 * lane + 256 * j) = v[j]; } }
#undef IN
#undef SEAM
}

extern "C" void kernel_launch(void* const* d_in, const int* in_sizes, int n_in, void* d_out, int out_size, void* d_ws, size_t ws_size, hipStream_t stream) {
    static int grid = 0;
    if (grid == 0) {
        if (n_in != 34 || in_sizes[0] != NTOK * DM || out_size != NTOK * DM || ws_size < WS_END) {
            fprintf(stderr, "kernel_launch: shape/workspace mismatch: n_in %d in0 %d out %d ws %zu (need %zu)\n", n_in, n_in > 0 ? in_sizes[0] : -1, out_size, ws_size, (size_t)WS_END); grid = -1; return; }
        int dev = 0, cus = 0;
        if (hipGetDevice(&dev) != hipSuccess || hipDeviceGetAttribute(&cus, hipDeviceAttributeMultiprocessorCount, dev) != hipSuccess) { grid = -1; return; }
        if (hipFuncSetAttribute((const void*)fwd_kernel, hipFuncAttributeMaxDynamicSharedMemorySize, LDS_BYTES) != hipSuccess) { fprintf(stderr, "kernel_launch: hipFuncSetAttribute failed\n"); grid = -1; return; }
        int per_cu = 0;
        if (hipOccupancyMaxActiveBlocksPerMultiprocessor(&per_cu, (const void*)fwd_kernel, NTHR, LDS_BYTES) != hipSuccess || per_cu < 1) {
            fprintf(stderr, "kernel_launch: occupancy query reports %d blocks per CU; nothing launched\n", per_cu); (void)hipGetLastError(); grid = -1; return; }
        grid = cus;
    }
    if (grid < 0) return;
    (void)hipMemsetAsync((char*)d_ws + WS_CTL, 0, CTL_BYTES, stream);
    Args a{};
    for (int i = 0; i < 34; ++i) a.in[i] = (const float*)d_in[i];
    a.out = (float*)d_out; a.ws = (unsigned char*)d_ws;
#if MK_ONE
    a.ph_lo = 0; a.ph_hi = N_PHASES;
    void* kargs[] = {&a};
    hipError_t e = hipLaunchCooperativeKernel((const void*)fwd_kernel, dim3(grid), dim3(NTHR), kargs, LDS_BYTES, stream);
    if (e != hipSuccess) fprintf(stderr, "kernel_launch: cooperative launch failed: %s (grid %d)\n", hipGetErrorString(e), grid);
#else
    for (int p = 0; p < N_PHASES; ++p) {
        a.ph_lo = p; a.ph_hi = p + 1;
        hipLaunchKernelGGL(fwd_kernel, dim3(grid), dim3(NTHR), LDS_BYTES, stream, a);
    }
#endif
}
```

```cpp
#include <hip/hip_runtime.h>
#include <hip/hip_cooperative_groups.h>
#include <cstdio>
#include <cstdint>

#define LAS __attribute__((address_space(3)))
#define GAS __attribute__((address_space(1)))
typedef unsigned short bf16;
typedef short bf16x8 __attribute__((ext_vector_type(8)));
typedef float f32x4 __attribute__((ext_vector_type(4)));
typedef float f32x2 __attribute__((ext_vector_type(2)));
typedef unsigned u32x4 __attribute__((ext_vector_type(4)));
typedef unsigned u32x2 __attribute__((ext_vector_type(2)));

#ifndef MK_ONE
#define MK_ONE 1
#endif

constexpr int BATCH = 8, SEQ = 4096, DM = 1024, NTOK = BATCH * SEQ, NU = 3072;
constexpr int NWAVES = 8, NTHR = 512;
constexpr float EPS = 1e-6f;
constexpr int N_PHASES = 18;
constexpr int LDS_BYTES = 160 * 1024;

constexpr size_t MiB = 1u << 20;
constexpr size_t WS_CTL = 0, CTL_BYTES = 64 * 1024;
constexpr size_t WS_ROPE = 1 * MiB;
constexpr size_t WS_HDN = 2 * MiB;
constexpr size_t WS_TAPS = 3 * MiB;
constexpr size_t WS_NRM = 30 * MiB;
constexpr size_t WS_GATES = 19 * MiB;
constexpr size_t WS_RSTD1 = 21 * MiB;
constexpr size_t WS_RINFO = 22 * MiB;
constexpr size_t WS_WIN0 = 32 * MiB, WS_WOUT0 = 38 * MiB, WS_WIN1 = 40 * MiB, WS_WOUT1 = 46 * MiB;
constexpr size_t WS_W13 = 48 * MiB, WS_W2 = 112 * MiB;
constexpr size_t WS_HN = 144 * MiB;
constexpr size_t WS_U = 208 * MiB;
constexpr size_t WS_Y = 208 * MiB;
constexpr size_t WS_HID = 336 * MiB;
constexpr size_t WS_SCR = 400 * MiB;
constexpr size_t WS_ZT = WS_SCR, WS_YT = WS_SCR + 32 * MiB, WS_KF = WS_SCR + 64 * MiB;
constexpr size_t WS_HF = WS_SCR, WS_HB = WS_SCR + 64 * MiB;
constexpr size_t WS_XB = WS_SCR + 48 * MiB;
constexpr size_t WS_END = 528 * MiB;
constexpr int CW_FFT = 48, CW_CUR0 = 64, CW_CUR1 = 128, CW_TCNT0 = 1024, CW_TCNT1 = 1536, CW_OPT0 = 2048, CW_OPT1 = 2304;
constexpr int MOE_CAP = 32768;

struct Args { const float* in[34]; float* out; unsigned char* ws; int ph_lo, ph_hi; };
struct DArgs {
    const char* ka; float* out; unsigned char* ws;
    template <int I> __device__ __forceinline__ const float* in() const { unsigned long long v;
        asm volatile("s_load_dwordx2 %0, %1, %2\n\ts_waitcnt lgkmcnt(0)" : "=s"(v) : "s"(ka), "n"(I * 8) : "memory"); return (const float*)(const GAS float*)v; }
};

__device__ __forceinline__ unsigned f2bf(float f) { unsigned u = __builtin_bit_cast(unsigned, f); return (u + 0x7fffu + ((u >> 16) & 1u)) >> 16; }
typedef __bf16 bf16x2_t __attribute__((ext_vector_type(2)));
__device__ __forceinline__ unsigned pk2(float lo, float hi) { f32x2 v = {lo, hi}; bf16x2_t b = __builtin_convertvector(v, bf16x2_t); return __builtin_bit_cast(unsigned, b); }
__device__ __forceinline__ float bflo(unsigned w) { return __builtin_bit_cast(float, w << 16); }
__device__ __forceinline__ float bfhi(unsigned w) { return __builtin_bit_cast(float, w & 0xffff0000u); }
__device__ __forceinline__ float bf2f(bf16 h) { return __builtin_bit_cast(float, (unsigned)h << 16); }
template <int CTRL> __device__ __forceinline__ float dpp_mov(float v) { return __builtin_bit_cast(float, __builtin_amdgcn_update_dpp(0, __builtin_bit_cast(int, v), CTRL, 0xf, 0xf, true)); }
__device__ __forceinline__ float quad_sum(float v) { v += dpp_mov<0xB1>(v); v += dpp_mov<0x4E>(v); return v; }
__device__ __forceinline__ float row16_sum(float v) { v = quad_sum(v); v += dpp_mov<0x141>(v); v += dpp_mov<0x140>(v); return v; }
__device__ __forceinline__ float wave_sum(float v) {
    v = row16_sum(v);
    v += __builtin_bit_cast(float, __builtin_amdgcn_update_dpp(0, __builtin_bit_cast(int, v), 0x142, 0xA, 0xF, false));
    v += __builtin_bit_cast(float, __builtin_amdgcn_update_dpp(0, __builtin_bit_cast(int, v), 0x143, 0xC, 0xF, false));
    return __builtin_bit_cast(float, __builtin_amdgcn_readlane(__builtin_bit_cast(int, v), 63));
}
__device__ __forceinline__ int opaque_tid() { int t = threadIdx.x; asm volatile("" : "+v"(t)); return t; }
#define LDS_WAIT() asm volatile("s_waitcnt lgkmcnt(0)" ::: "memory")
#define VM_WAIT() asm volatile("s_waitcnt vmcnt(0)" ::: "memory")
__device__ __forceinline__ float sigmoidf_(float x) { return __builtin_amdgcn_rcpf(1.f + __expf(-x)); }
__device__ __forceinline__ float siluf_(float x) { return x * __builtin_amdgcn_rcpf(1.f + __expf(-x)); }

namespace pg8 {
constexpr int BM = 256, BK = 64, HALF = 128, HTB = HALF * BK * 2, NXCD = 8, WGM = 8;
__host__ __device__ __forceinline__ int lds_byte(int r, int c) { const int st = (r >> 4) * 2 + (c >> 5), rr = r & 15, cc = c & 31, ob = rr * 64 + cc * 2; return st * 1024 + (ob ^ (((ob >> 9) & 1) << 5)); }
__host__ __device__ __forceinline__ void stage_rc(int b, int& R, int& C) { const int st = b / 1024, sb = b % 1024, swz = sb ^ (((sb >> 9) & 1) << 5); R = (st >> 1) * 16 + swz / 64; C = (st & 1) * 32 + (swz % 64) / 2; }
__host__ __device__ __forceinline__ int perm32(int rho) { const int n = rho >> 4, i = rho & 15; return 8 * (i >> 2) + 4 * n + (i & 3); }

struct Unit { const char* A; const char* B; int pm, pn, aux, nvalid; const int* rows; };

struct StaticOrder {
    int nM, nN, nwg, G, c;
    __device__ void init(int M, int N, int G_, int c_) { nM = M / BM; nN = N / BM; nwg = nM * nN; G = G_; c = c_; }
    __device__ bool next(int i, int& pm, int& pn) const {
        const long L = (long)i * G + c; if (L >= nwg) return false;
        int wgid = (int)L; { const int q = nwg / NXCD, r = nwg % NXCD, xcd = wgid % NXCD, off = wgid / NXCD; wgid = (xcd < r ? xcd * (q + 1) : r * (q + 1) + (xcd - r) * q) + off; }
        const int nig = WGM * nN, gid = wgid / nig, fm = gid * WGM, gsz = (nM - fm) < WGM ? (nM - fm) : WGM;
        pm = fm + ((wgid % nig) % gsz); pn = (wgid % nig) / gsz; return true;
    }
};
struct DenseSched {
    StaticOrder so; const char* A; const char* Bt; size_t tstep; unsigned* tcnt;
    __device__ void init(const bf16* A_, const bf16* Bt_, int M, int N, int K, int G, int c, unsigned* tcnt_ = nullptr) { so.init(M, N, G, c); A = (const char*)A_; Bt = (const char*)Bt_; tstep = (size_t)BM * K * 2; tcnt = tcnt_; }
    __device__ __forceinline__ bool next(int i, Unit& u) const { int pm, pn; if (!so.next(i, pm, pn)) return false; u.pm = pm; u.pn = pn; u.aux = 0; u.nvalid = 256; u.rows = nullptr; u.A = A + (size_t)pm * tstep; u.B = Bt + (size_t)pn * tstep; return true; }
    __device__ __forceinline__ void a_ready(const Unit&) const {}
    __device__ __forceinline__ void done(const Unit& u) const {
        if (tcnt == nullptr) return;
        asm volatile("s_waitcnt vmcnt(0)" ::: "memory");
        if ((threadIdx.x & 63) == 0) (void)__hip_atomic_fetch_add(tcnt + u.pm, 1u, __ATOMIC_RELAXED, __HIP_MEMORY_SCOPE_AGENT);
    }
};

template <class Epi, class Sched, bool GATHER>
__device__ __forceinline__ void gemm_phase(LAS unsigned char* lds, const int K, const Sched& S, const Epi& E) {
    const int tid = opaque_tid(), wid = __builtin_amdgcn_readfirstlane(tid >> 6), lane = tid & 63, wr = wid >> 2, wc = wid & 3, fr = lane & 15, fq = lane >> 4;
    const int nt = K / BK;
    unsigned voffA[2][2], voffAn[2][2], voffB[2]; int Rr[2], Cc[2];
#pragma unroll
    for (int i = 0; i < 2; ++i) { int R, C; stage_rc(tid * 16 + i * 8192, R, C); const int Rb = 64 * (R >> 5) + perm32(R & 31);
        Rr[i] = R; Cc[i] = C; voffB[i] = (unsigned)(Rb * K + C) * 2u;
        voffA[0][i] = (unsigned)(R * K + C) * 2u; voffA[1][i] = (unsigned)((R + HALF) * K + C) * 2u; voffAn[0][i] = voffA[0][i]; voffAn[1][i] = voffA[1][i]; }
    const size_t kstep = (size_t)(BK * 2);
    const size_t hstep = (size_t)32 * K * 2;
    const unsigned ldsw = (unsigned)wid * 1024u;
    const int aoff = lds_byte(wr * 64 + fr, fq * 8), boff = lds_byte(wc * 32 + fr, fq * 8);
#define PG8_SA(b, h) (((b) * 2 + (h)) * HTB)
#define PG8_SB(b, h) ((4 + (b) * 2 + (h)) * HTB)
#define PG8_STAGE(bufoff, gbase, voff) do { _Pragma("unroll") for (int _i = 0; _i < 2; ++_i) \
        __builtin_amdgcn_global_load_lds((const unsigned*)((const char*)(gbase) + (voff)[_i]), (LAS unsigned*)(lds + (bufoff) + ldsw + _i * 8192), 16, 0, 0); } while (0)
#define PG8_LDA(dst, b, h) do { _Pragma("unroll") for (int m = 0; m < 4; ++m) _Pragma("unroll") for (int k = 0; k < 2; ++k) dst[m][k] = *(const LAS bf16x8*)(lds + PG8_SA(b, h) + aoff + m * 2048 + k * 1024); } while (0)
#define PG8_LDB(dst, b, h) do { _Pragma("unroll") for (int n = 0; n < 2; ++n) _Pragma("unroll") for (int k = 0; k < 2; ++k) dst[n][k] = *(const LAS bf16x8*)(lds + PG8_SB(b, h) + boff + n * 2048 + k * 1024); } while (0)
#define PG8_MMA(ai, bj, At, Bt) do { __builtin_amdgcn_s_setprio(1); _Pragma("unroll") for (int m = 0; m < 4; ++m) _Pragma("unroll") for (int n = 0; n < 2; ++n) _Pragma("unroll") for (int k = 0; k < 2; ++k) \
        acc[ai][bj][m][n] = __builtin_amdgcn_mfma_f32_16x16x32_bf16(Bt[n][k], At[m][k], acc[ai][bj][m][n], 0, 0, 0); __builtin_amdgcn_s_setprio(0); } while (0)
#define PG8_WAIT_V(n) asm volatile("s_waitcnt vmcnt(" #n ")" ::: "memory")
#define PG8_WAIT_L(n) asm volatile("s_waitcnt lgkmcnt(" #n ")" ::: "memory")
#define PG8_BAR __builtin_amdgcn_s_barrier()
#define PG8_SCHED __builtin_amdgcn_sched_barrier(0)
#define PG8_GVOFF(dst, u) do { if constexpr (GATHER) { _Pragma("unroll") for (int _h = 0; _h < 2; ++_h) _Pragma("unroll") for (int _i = 0; _i < 2; ++_i) { \
        const int _r = _h * HALF + Rr[_i]; int _row = 0; if (_r < (u).nvalid) _row = (u).rows[2 * _r] >> 1; dst[_h][_i] = (unsigned)(_row * K + Cc[_i]) * 2u; } } } while (0)
    Unit cur, nxt; int ui = 0;
    if (!S.next(0, cur)) return;
    f32x4 acc[2][2][4][2];
#pragma unroll
    for (int a = 0; a < 2; ++a)
#pragma unroll
        for (int b = 0; b < 2; ++b)
#pragma unroll
            for (int m = 0; m < 4; ++m)
#pragma unroll
                for (int n = 0; n < 2; ++n) acc[a][b][m][n] = (f32x4){0.f, 0.f, 0.f, 0.f};
    bf16x8 At[4][2], B0[2][2], B1[2][2];
    const char* cA = cur.A; const char* cB = cur.B;
    S.a_ready(cur);
    PG8_GVOFF(voffA, cur);
    PG8_STAGE(PG8_SB(0, 0), cB, voffB); PG8_STAGE(PG8_SB(0, 1), cB + hstep, voffB); PG8_STAGE(PG8_SA(0, 0), cA, voffA[0]); PG8_STAGE(PG8_SA(0, 1), cA, voffA[1]);
    if (wr == 1) PG8_BAR;
    PG8_WAIT_V(2); PG8_BAR;
    PG8_STAGE(PG8_SB(1, 0), cB + kstep, voffB); PG8_STAGE(PG8_SA(1, 0), cA + kstep, voffA[0]); PG8_STAGE(PG8_SB(1, 1), cB + hstep + kstep, voffB);
    PG8_WAIT_V(6); PG8_BAR;
    for (;;) {
        const bool has_next = S.next(ui + 1, nxt);
        const char* nA = has_next ? nxt.A : cA; const char* nB = has_next ? nxt.B : cB;
        if constexpr (GATHER) { if (has_next) { PG8_GVOFF(voffAn, nxt); } else {
#pragma unroll
            for (int h = 0; h < 2; ++h)
#pragma unroll
                for (int i = 0; i < 2; ++i) voffAn[h][i] = voffA[h][i]; } }
        for (int t = 0; t < nt; t += 2) {
            const bool last = (t == nt - 2);
            if (last && has_next) S.a_ready(nxt);
            const char* a1 = cA + (size_t)(t + 1) * kstep;
            const char* a2 = last ? nA : cA + (size_t)(t + 2) * kstep; const char* b2 = last ? nB : cB + (size_t)(t + 2) * kstep;
            const char* a3 = a2 + kstep; const char* b3 = b2 + kstep;
            unsigned va2[2][2];
#pragma unroll
            for (int h = 0; h < 2; ++h)
#pragma unroll
                for (int i = 0; i < 2; ++i) va2[h][i] = (GATHER && last) ? voffAn[h][i] : voffA[h][i];
            PG8_LDB(B0, 0, 0); PG8_LDB(B1, 0, 1); PG8_SCHED; PG8_LDA(At, 0, 0); PG8_STAGE(PG8_SA(1, 1), a1, voffA[1]);
            PG8_WAIT_V(8); PG8_WAIT_L(0); PG8_BAR; PG8_MMA(0, 0, At, B0); PG8_MMA(0, 1, At, B1); PG8_BAR; PG8_SCHED;
            PG8_LDA(At, 0, 1); PG8_STAGE(PG8_SB(0, 0), b2, voffB); PG8_STAGE(PG8_SB(0, 1), b2 + hstep, voffB); PG8_STAGE(PG8_SA(0, 0), a2, va2[0]);
            PG8_WAIT_V(8); PG8_WAIT_L(0); PG8_BAR; PG8_MMA(1, 0, At, B0); PG8_MMA(1, 1, At, B1); PG8_BAR; PG8_SCHED;
            PG8_LDB(B0, 1, 0); PG8_LDB(B1, 1, 1); PG8_SCHED; PG8_LDA(At, 1, 0); PG8_STAGE(PG8_SA(0, 1), a2, va2[1]);
            PG8_WAIT_V(8); PG8_WAIT_L(0); PG8_BAR; PG8_MMA(0, 0, At, B0); PG8_MMA(0, 1, At, B1); PG8_BAR; PG8_SCHED;
            PG8_LDA(At, 1, 1); PG8_STAGE(PG8_SB(1, 0), b3, voffB); PG8_STAGE(PG8_SB(1, 1), b3 + hstep, voffB); PG8_STAGE(PG8_SA(1, 0), a3, va2[0]);
            PG8_WAIT_V(8); PG8_WAIT_L(0); PG8_BAR; PG8_MMA(1, 0, At, B0); PG8_MMA(1, 1, At, B1); PG8_BAR; PG8_SCHED;
        }
        if (wr == 0) PG8_BAR;
        E(acc, cur, wr, wc, fr, fq); S.done(cur);
        if (!has_next) break;
#pragma unroll
        for (int a = 0; a < 2; ++a)
#pragma unroll
            for (int b = 0; b < 2; ++b)
#pragma unroll
                for (int m = 0; m < 4; ++m)
#pragma unroll
                    for (int n = 0; n < 2; ++n) acc[a][b][m][n] = (f32x4){0.f, 0.f, 0.f, 0.f};
        cur = nxt; cA = nA; cB = nB; ++ui;
        if (wr == 1) PG8_BAR;
        if constexpr (GATHER) {
#pragma unroll
            for (int h = 0; h < 2; ++h)
#pragma unroll
                for (int i = 0; i < 2; ++i) voffA[h][i] = voffAn[h][i]; }
    }
    PG8_WAIT_V(0);
    PG8_BAR;
#undef PG8_SA
#undef PG8_SB
#undef PG8_STAGE
#undef PG8_LDA
#undef PG8_LDB
#undef PG8_MMA
#undef PG8_WAIT_V
#undef PG8_WAIT_L
#undef PG8_BAR
#undef PG8_SCHED
#undef PG8_GVOFF
}

struct EpiBf16 {
    bf16* O; int ldc;
    __device__ __forceinline__ void operator()(const f32x4 (&acc)[2][2][4][2], const Unit& u, int wr, int wc, int fr, int fq) const {
        const int row0 = u.pm * BM + wr * 64 + fr, col0 = u.pn * BM + wc * 64 + 8 * fq;
#pragma unroll
        for (int ai = 0; ai < 2; ++ai)
#pragma unroll
            for (int m = 0; m < 4; ++m) { bf16* rowp = O + (size_t)(row0 + ai * HALF + m * 16) * ldc + col0;
#pragma unroll
                for (int bj = 0; bj < 2; ++bj) { const f32x4 v0 = acc[ai][bj][m][0], v1 = acc[ai][bj][m][1];
                    u32x4 w; w.x = pk2(v0[0], v0[1]); w.y = pk2(v0[2], v0[3]); w.z = pk2(v1[0], v1[1]); w.w = pk2(v1[2], v1[3]);
                    *(u32x4*)(rowp + bj * 32) = w; } }
    }
};
struct EpiBf16RowScale {
    bf16* O; int ldc; const float* rs;
    __device__ __forceinline__ void operator()(const f32x4 (&acc)[2][2][4][2], const Unit& u, int wr, int wc, int fr, int fq) const {
        const int row0 = u.pm * BM + wr * 64 + fr, col0 = u.pn * BM + wc * 64 + 8 * fq;
        float sc[2][4];
#pragma unroll
        for (int ai = 0; ai < 2; ++ai)
#pragma unroll
            for (int m = 0; m < 4; ++m) sc[ai][m] = rs[row0 + ai * HALF + m * 16];
#pragma unroll
        for (int ai = 0; ai < 2; ++ai)
#pragma unroll
            for (int m = 0; m < 4; ++m) { bf16* rowp = O + (size_t)(row0 + ai * HALF + m * 16) * ldc + col0; const float q = sc[ai][m];
#pragma unroll
                for (int bj = 0; bj < 2; ++bj) { const f32x4 v0 = acc[ai][bj][m][0] * q, v1 = acc[ai][bj][m][1] * q;
                    u32x4 w; w.x = pk2(v0[0], v0[1]); w.y = pk2(v0[2], v0[3]); w.z = pk2(v1[0], v1[1]); w.w = pk2(v1[2], v1[3]);
                    *(u32x4*)(rowp + bj * 32) = w; } }
    }
};
struct EpiQKV0 {
    bf16* O; int ldc; const float* gq; const float* gk; const float* ct; const float* st;
    __device__ __forceinline__ void operator()(const f32x4 (&acc)[2][2][4][2], const Unit& u, int wr, int wc, int fr, int fq) const {
        const int row0 = u.pm * BM + wr * 64 + fr, col0 = u.pn * BM + wc * 64 + 8 * fq;
        if (u.pn >= 4) {
#pragma unroll
            for (int ai = 0; ai < 2; ++ai)
#pragma unroll
                for (int m = 0; m < 4; ++m) { bf16* rowp = O + (size_t)(row0 + ai * HALF + m * 16) * ldc + col0;
#pragma unroll
                    for (int bj = 0; bj < 2; ++bj) { const f32x4 v0 = acc[ai][bj][m][0], v1 = acc[ai][bj][m][1];
                        u32x4 w; w.x = pk2(v0[0], v0[1]); w.y = pk2(v0[2], v0[3]); w.z = pk2(v1[0], v1[1]); w.w = pk2(v1[2], v1[3]);
                        *(u32x4*)(rowp + bj * 32) = w; } }
            return; }
        const bool isq = u.pn < 2; const float* gs = (isq ? gq : gk) + 8 * fq;
        const f32x4 g00 = *(const f32x4*)gs, g01 = *(const f32x4*)(gs + 4), g10 = *(const f32x4*)(gs + 32), g11 = *(const f32x4*)(gs + 36);
        const float sc = isq ? 0.125f * 1.4426950408889634f : 1.f;
        const float sgn = (fq == 0) ? -1.f : 1.f; const bool ropel = fq < 2;
#pragma unroll
        for (int ai = 0; ai < 2; ++ai)
#pragma unroll
            for (int m = 0; m < 4; ++m) { const int row = row0 + ai * HALF + m * 16; const int spos = row & (SEQ - 1);
                f32x4 v00 = acc[ai][0][m][0], v01 = acc[ai][0][m][1], v10 = acc[ai][1][m][0], v11 = acc[ai][1][m][1];
                float ss = (v00[0] * v00[0] + v00[1] * v00[1]) + (v00[2] * v00[2] + v00[3] * v00[3]) + (v01[0] * v01[0] + v01[1] * v01[1]) + (v01[2] * v01[2] + v01[3] * v01[3])
                         + (v10[0] * v10[0] + v10[1] * v10[1]) + (v10[2] * v10[2] + v10[3] * v10[3]) + (v11[0] * v11[0] + v11[1] * v11[1]) + (v11[2] * v11[2] + v11[3] * v11[3]);
                { auto rr = __builtin_amdgcn_permlane16_swap(__float_as_uint(ss), __float_as_uint(ss), false, false); ss = __uint_as_float(rr[0]) + __uint_as_float(rr[1]); }
                { auto rr = __builtin_amdgcn_permlane32_swap(__float_as_uint(ss), __float_as_uint(ss), false, false); ss = __uint_as_float(rr[0]) + __uint_as_float(rr[1]); }
                const float rstd = __frsqrt_rn(ss * (1.f / 64.f) + EPS);
                v00 = v00 * rstd * g00; v01 = v01 * rstd * g01; v10 = v10 * rstd * g10; v11 = v11 * rstd * g11;
                const f32x4 c0 = *(const f32x4*)(ct + spos * 8), c1 = *(const f32x4*)(ct + spos * 8 + 4), s0 = *(const f32x4*)(st + spos * 8), s1 = *(const f32x4*)(st + spos * 8 + 4);
                f32x4 p0, p1;
#pragma unroll
                for (int j = 0; j < 4; ++j) {
                    { auto rr = __builtin_amdgcn_permlane16_swap(__float_as_uint(v00[j]), __float_as_uint(v00[j]), false, false); p0[j] = __uint_as_float((fq & 1) ? rr[0] : rr[1]); }
                    { auto rr = __builtin_amdgcn_permlane16_swap(__float_as_uint(v01[j]), __float_as_uint(v01[j]), false, false); p1[j] = __uint_as_float((fq & 1) ? rr[0] : rr[1]); } }
                if (ropel) { v00 = v00 * c0 + p0 * s0 * sgn; v01 = v01 * c1 + p1 * s1 * sgn; }
                v00 = v00 * sc; v01 = v01 * sc; v10 = v10 * sc; v11 = v11 * sc;
                bf16* rowp = O + (size_t)row * ldc + col0;
                u32x4 w; w.x = pk2(v00[0], v00[1]); w.y = pk2(v00[2], v00[3]); w.z = pk2(v01[0], v01[1]); w.w = pk2(v01[2], v01[3]);
                *(u32x4*)rowp = w;
                w.x = pk2(v10[0], v10[1]); w.y = pk2(v10[2], v10[3]); w.z = pk2(v11[0], v11[1]); w.w = pk2(v11[2], v11[3]);
                *(u32x4*)(rowp + 32) = w; }
    }
};
template <bool RES_F32> struct EpiResBf16 {
    const void* res; bf16* out; int ldc;
    __device__ __forceinline__ void operator()(const f32x4 (&acc)[2][2][4][2], const Unit& u, int wr, int wc, int fr, int fq) const {
        const int row0 = u.pm * BM + wr * 64 + fr, col0 = u.pn * BM + wc * 64 + 8 * fq;
#pragma unroll
        for (int ai = 0; ai < 2; ++ai)
#pragma unroll
            for (int m = 0; m < 4; ++m) { const size_t ro = (size_t)(row0 + ai * HALF + m * 16) * ldc + col0;
#pragma unroll
                for (int bj = 0; bj < 2; ++bj) { f32x4 r0, r1;
                    if (RES_F32) { const float* rp = (const float*)res + ro + bj * 32; r0 = *(const f32x4*)rp; r1 = *(const f32x4*)(rp + 4); }
                    else { const u32x4 w = *(const u32x4*)((const bf16*)res + ro + bj * 32); r0 = (f32x4){bflo(w.x), bfhi(w.x), bflo(w.y), bfhi(w.y)}; r1 = (f32x4){bflo(w.z), bfhi(w.z), bflo(w.w), bfhi(w.w)}; }
                    const f32x4 v0 = r0 + acc[ai][bj][m][0], v1 = r1 + acc[ai][bj][m][1];
                    u32x4 o; o.x = pk2(v0[0], v0[1]); o.y = pk2(v0[2], v0[3]); o.z = pk2(v1[0], v1[1]); o.w = pk2(v1[2], v1[3]);
                    asm volatile("global_store_dwordx4 %0, %1, off sc1\n\ts_nop 1" :: "v"(out + ro + bj * 32), "v"(o) : "memory"); } }
    }
};
struct EpiSwiGLU {
    bf16* H;
    __device__ __forceinline__ void operator()(const f32x4 (&acc)[2][2][4][2], const Unit& u, int wr, int wc, int fr, int fq) const {
        const int row0 = u.pm * BM + wr * 64 + fr, col0 = u.pn * 128 + wc * 32 + 8 * fq;
#pragma unroll
        for (int ai = 0; ai < 2; ++ai)
#pragma unroll
            for (int m = 0; m < 4; ++m) { bf16* rowp = H + (size_t)(row0 + ai * HALF + m * 16) * 512 + col0;
                float h[8];
#pragma unroll
                for (int n = 0; n < 2; ++n)
#pragma unroll
                    for (int j = 0; j < 4; ++j) { const float a = acc[ai][0][m][n][j], b = acc[ai][1][m][n][j]; h[n * 4 + j] = siluf_(a) * b; }
                u32x4 w; w.x = pk2(h[0], h[1]); w.y = pk2(h[2], h[3]); w.z = pk2(h[4], h[5]); w.w = pk2(h[6], h[7]);
                asm volatile("global_store_dwordx4 %0, %1, off sc1\n\ts_nop 1" :: "v"(rowp), "v"(w) : "memory"); }
    }
};
struct EpiMoeOut {
    bf16* Y;
    __device__ __forceinline__ void operator()(const f32x4 (&acc)[2][2][4][2], const Unit& u, int wr, int wc, int fr, int fq) const {
        const int col0 = u.pn * BM + wc * 64 + 8 * fq;
        int slot[2][4]; float gate[2][4];
#pragma unroll
        for (int ai = 0; ai < 2; ++ai)
#pragma unroll
            for (int m = 0; m < 4; ++m) { const int r = ai * HALF + wr * 64 + m * 16 + fr; slot[ai][m] = -1; gate[ai][m] = 0.f;
                if (r < u.nvalid) { slot[ai][m] = u.rows[2 * r]; gate[ai][m] = __builtin_bit_cast(float, u.rows[2 * r + 1]); } }
#pragma unroll
        for (int ai = 0; ai < 2; ++ai)
#pragma unroll
            for (int m = 0; m < 4; ++m) {
                if (slot[ai][m] >= 0) { const float g = gate[ai][m];
                    bf16* rowp = Y + (size_t)slot[ai][m] * 1024 + col0;
#pragma unroll
                    for (int bj = 0; bj < 2; ++bj) { const f32x4 v0 = acc[ai][bj][m][0] * g, v1 = acc[ai][bj][m][1] * g;
                        u32x4 w; w.x = pk2(v0[0], v0[1]); w.y = pk2(v0[2], v0[3]); w.z = pk2(v1[0], v1[1]); w.w = pk2(v1[2], v1[3]);
                        *(u32x4*)(rowp + bj * 32) = w; } } }
    }
};
struct MoeSched {
    const LAS int* tpre;
    const LAS int* cnt;
    const LAS int* xe;
    const int* rinfo;
    const char* A; const char* W; int K; size_t wstride_e; bool gather; int G, c, ntiles;
    unsigned* tcnt; int mode;
    __device__ __forceinline__ bool next(int i, Unit& u) const {
        const int nb = G >> 3, j0 = c >> 3, j = (mode == 2) ? nb - 1 - j0 : j0;
        const int un = i * nb + j, lt = un >> 2, pn = un & 3;
        int e = -1, local = 0, acc = 0;
#pragma unroll
        for (int k = 0; k < 4; ++k) { const int ek = __builtin_amdgcn_readfirstlane(xe[k]), nk = __builtin_amdgcn_readfirstlane(tpre[ek + 1]) - __builtin_amdgcn_readfirstlane(tpre[ek]);
            if (e < 0 && lt < acc + nk) { e = ek; local = lt - acc; } acc += nk; }
        if (e < 0) return false;
        const int t = __builtin_amdgcn_readfirstlane(tpre[e]) + local;
        u.pm = t; u.pn = pn; u.aux = e; u.nvalid = min(256, __builtin_amdgcn_readfirstlane(cnt[e]) - local * 256); u.rows = rinfo + ((size_t)e * MOE_CAP + (size_t)local * 256) * 2;
        u.A = gather ? A : A + (size_t)t * 256 * K * 2; u.B = W + (size_t)e * wstride_e + (size_t)pn * 256 * K * 2; return true;
    }
    __device__ __forceinline__ void a_ready(const Unit& u) const {
        if (mode != 2) return;
        if (threadIdx.x < 64) { unsigned polls = 0;
            while ((unsigned)__builtin_amdgcn_readfirstlane(__hip_atomic_load(tcnt + u.pm, __ATOMIC_RELAXED, __HIP_MEMORY_SCOPE_AGENT)) < 32u) { __builtin_amdgcn_s_sleep(2); if (++polls > (1u << 22)) break; }
            __builtin_amdgcn_fence(__ATOMIC_ACQUIRE, "agent");
            asm volatile("s_waitcnt vmcnt(0)" ::: "memory"); }
        asm volatile("" ::: "memory"); __builtin_amdgcn_s_barrier(); asm volatile("" ::: "memory");
    }
    __device__ __forceinline__ void done(const Unit& u) const {
        if (mode != 1) return;
        asm volatile("s_waitcnt vmcnt(0)" ::: "memory");
        if ((threadIdx.x & 63) == 0) (void)__hip_atomic_fetch_add(tcnt + u.pm, 1u, __ATOMIC_RELAXED, __HIP_MEMORY_SCOPE_AGENT);
    }
};
}

#define XP_LOAD(r, src, ldw) do { _Pragma("unroll") for (int _i = 0; _i < 32; ++_i) r[_i] = (src)[(size_t)(2 * _i + (lane >> 5)) * (ldw) + (lane & 31)]; } while (0)
#define XP_STORE(r, dst, Kdst) do { _Pragma("unroll") for (int _i = 0; _i < 32; ++_i) scr[(2 * _i + (lane >> 5)) * 33 + (lane & 31)] = r[_i]; \
    LDS_WAIT(); asm volatile("" ::: "memory"); } while (0)
#define XP_WRITE(dst, Kdst) do { const int _c = lane & 7; _Pragma("unroll") for (int _j = 0; _j < 4; ++_j) { const int _n = (lane >> 3) + 8 * _j; const LAS float* _s = scr + (8 * _c) * 33 + _n; \
    u32x4 _o; _o.x = pk2(_s[0 * 33], _s[1 * 33]); _o.y = pk2(_s[2 * 33], _s[3 * 33]); _o.z = pk2(_s[4 * 33], _s[5 * 33]); _o.w = pk2(_s[6 * 33], _s[7 * 33]); \
    *(u32x4*)((dst) + (size_t)_n * (Kdst) + 8 * _c) = _o; } LDS_WAIT(); asm volatile("" ::: "memory"); } while (0)
__device__ __forceinline__ void moe_item_desc(const float* w1, const float* w3, const float* w2, bf16* W13, bf16* W2, int it, const float*& src, int& ldw, bf16*& dst, int& Kdst) {
    const int e = it / 768, r = it % 768;
    if (r < 512) { const int rr = r & 255, kb = rr >> 4, nb = rr & 15, n0 = 32 * nb, k0 = 64 * kb; const int drow0 = 256 * (n0 >> 7) + 64 * ((n0 & 127) >> 5) + (r < 256 ? 0 : 32);
        src = (r < 256 ? w1 : w3) + (size_t)e * 1024 * 512 + (size_t)k0 * 512 + n0; ldw = 512; dst = W13 + (size_t)e * 1024 * 1024 + (size_t)drow0 * 1024 + k0; Kdst = 1024; }
    else { const int rr = r - 512, kb = rr >> 5, nb = rr & 31, k0 = 64 * kb, n0 = 32 * nb;
        src = w2 + (size_t)e * 512 * 1024 + (size_t)k0 * 1024 + n0; ldw = 1024; dst = W2 + (size_t)e * 1024 * 512 + (size_t)n0 * 512 + k0; Kdst = 512; }
}
__device__ __forceinline__ void moe_convert_items(const DArgs& a, int L, LAS float* scr, int gw, int ngw, int lane) {
    const float* w1 = a.in<31>() + (size_t)L * 32 * 1024 * 512; const float* w3 = a.in<32>() + (size_t)L * 32 * 1024 * 512; const float* w2 = a.in<33>() + (size_t)L * 32 * 512 * 1024;
    bf16* W13 = (bf16*)(a.ws + WS_W13); bf16* W2 = (bf16*)(a.ws + WS_W2);
    float r[32]; const float* src; int ldw; bf16* dst; int Kdst;
    if (gw >= 32 * 768) return;
    moe_item_desc(w1, w3, w2, W13, W2, gw, src, ldw, dst, Kdst); XP_LOAD(r, src, ldw);
    for (int it = gw; it < 32 * 768; it += ngw) {
        XP_STORE(r, dst, Kdst);
        bf16* dcur = dst; const int kcur = Kdst;
        if (it + ngw < 32 * 768) { moe_item_desc(w1, w3, w2, W13, W2, it + ngw, src, ldw, dst, Kdst); XP_LOAD(r, src, ldw); }
        XP_WRITE(dcur, kcur);
    }
}
__device__ __forceinline__ void dense_item_desc(const float* wi0, const float* wo0, const float* wi1, const float* wo1, unsigned char* ws, int it, const float*& src, int& ldw, bf16*& dst, int& ksc) {
    ksc = -1;
    if (it < 1536) { const int kb = it / 96, nb = it % 96; src = wi0 + (size_t)(64 * kb) * 3072 + 32 * nb; ldw = 3072; dst = (bf16*)(ws + WS_WIN0) + (size_t)(32 * nb) * 1024 + 64 * kb; }
    else if (it < 2048) { const int r = it - 1536, kb = r / 32, nb = r % 32; src = wo0 + (size_t)(64 * kb) * 1024 + 32 * nb; ldw = 1024; dst = (bf16*)(ws + WS_WOUT0) + (size_t)(32 * nb) * 1024 + 64 * kb; }
    else if (it < 3584) { const int r = it - 2048, kb = r / 96, nb = r % 96; src = wi1 + (size_t)(64 * kb) * 3088 + 32 * nb; ldw = 3088; dst = (bf16*)(ws + WS_WIN1) + (size_t)(32 * nb) * 1024 + 64 * kb; ksc = 64 * kb; }
    else { const int r = it - 3584, kb = r / 32, nb = r % 32; src = wo1 + (size_t)(64 * kb) * 1024 + 32 * nb; ldw = 1024; dst = (bf16*)(ws + WS_WOUT1) + (size_t)(32 * nb) * 1024 + 64 * kb; }
}
__device__ __forceinline__ void dense_convert_items(const DArgs& a, LAS float* scr, int gw, int ngw, int lane) {
    const float* wi0 = a.in<3>(); const float* wo0 = a.in<20>(); const float* wi1 = a.in<21>(); const float* wo1 = a.in<26>(); const float* g1 = a.in<1>() + 1024;
    float r[32]; const float* src; int ldw; bf16* dst; int ksc;
    if (gw >= 4096) return;
    dense_item_desc(wi0, wo0, wi1, wo1, a.ws, gw, src, ldw, dst, ksc); XP_LOAD(r, src, ldw);
    for (int it = gw; it < 4096; it += ngw) {
        if (ksc >= 0) {
#pragma unroll
            for (int i = 0; i < 32; ++i) r[i] *= g1[ksc + 2 * i + (lane >> 5)]; }
        XP_STORE(r, dst, 1024);
        bf16* dcur = dst;
        if (it + ngw < 4096) { dense_item_desc(wi0, wo0, wi1, wo1, a.ws, it + ngw, src, ldw, dst, ksc); XP_LOAD(r, src, ldw); }
        XP_WRITE(dcur, 1024);
    }
}
__device__ __forceinline__ float rms_row(f32x4 (&v)[4], const float* g, int lane) {
    float s = 0.f;
#pragma unroll
    for (int j = 0; j < 4; ++j) s += (v[j].x * v[j].x + v[j].y * v[j].y) + (v[j].z * v[j].z + v[j].w * v[j].w);
    const float rstd = __frsqrt_rn(wave_sum(s) * (1.f / DM) + EPS);
#pragma unroll
    for (int j = 0; j < 4; ++j) { const f32x4 gg = *(const f32x4*)(g + 4 * lane + 256 * j); v[j] = v[j] * rstd * gg; }
    return rstd;
}
__device__ __forceinline__ void store_row_bf16(bf16* orow, const f32x4 (&v)[4], int lane) {
#pragma unroll
    for (int j = 0; j < 4; ++j) { u32x2 w; w.x = pk2(v[j].x, v[j].y); w.y = pk2(v[j].z, v[j].w); *(u32x2*)(orow + 4 * lane + 256 * j) = w; }
}

__device__ __forceinline__ void load_row_bf16(const bf16* row, int lane, u32x2 (&w)[4]) {
#pragma unroll
    for (int j = 0; j < 4; ++j) w[j] = *(const u32x2*)(row + 4 * lane + 256 * j);
}
__device__ __forceinline__ void add_row_bf16(f32x4 (&v)[4], const u32x2 (&w)[4]) {
#pragma unroll
    for (int j = 0; j < 4; ++j) { v[j].x += bflo(w[j].x); v[j].y += bfhi(w[j].x); v[j].z += bflo(w[j].y); v[j].w += bfhi(w[j].y); }
}
__device__ __forceinline__ void phase_prep0(const DArgs& a, LAS unsigned char* lds, int vcu, int G) {
    const int tid = opaque_tid(), lane = tid & 63, wave = tid >> 6;
    LAS float* scr = (LAS float*)(lds + wave * 16384);
    const int gw = vcu * NWAVES + wave, ngw = G * NWAVES;
    unsigned char* ws = a.ws;
    dense_convert_items(a, scr, gw, ngw, lane);
    moe_convert_items(a, 0, scr, gw, ngw, lane);
    { float* ct = (float*)(ws + WS_ROPE); float* st = ct + SEQ * 8;
      for (int i = vcu * NTHR + tid; i < SEQ * 8; i += G * NTHR) { const int s = i >> 3, k = i & 7;
          const float inv = 1.0f / powf(500000.0f, (float)(2 * k) / 16.0f); const float ang = (float)s * inv; ct[i] = cosf(ang); st[i] = sinf(ang); } }
    { const float* w1 = a.in<13>(); const float* b1 = a.in<14>(); const float* fr = a.in<15>(); const float* w2 = a.in<16>(); const float* b2 = a.in<17>();
      float* hd = (float*)(ws + WS_HDN);
      for (int t = gw; t < SEQ; t += ngw) {
          float zf = 0.f;
          if (lane == 0) zf = (float)t / (float)(SEQ - 1);
          else if (lane < 33) { const int k = (lane - 1) & 15; const float band = 1e-4f + (float)k * ((15.0f - 1e-4f) / 15.0f);
              const float ang = (6.283185307179586f / (float)SEQ) * (float)t * band; zf = (lane < 17) ? cosf(ang) : -sinf(ang); }
          float acc = b1[lane];
          for (int j = 0; j < 33; ++j) acc += __shfl(zf, j) * w1[j * 64 + lane];
          const float h1 = sinf(fr[lane] * acc);
          float acc2 = b2[lane];
          for (int j = 0; j < 64; ++j) acc2 += __shfl(h1, j) * w2[j * 64 + lane];
          hd[t * 64 + lane] = sinf(fr[lane] * acc2);
      } }
    { const float* x = a.in<0>(); const float* g = a.in<1>(); bf16* hn = (bf16*)(ws + WS_HN);
      f32x4 v[4], nx[4];
#pragma unroll
      for (int j = 0; j < 4; ++j) nx[j] = *(const f32x4*)(x + (size_t)gw * DM + 4 * lane + 256 * j);
      for (int m = gw; m < NTOK; m += ngw) {
#pragma unroll
          for (int j = 0; j < 4; ++j) v[j] = nx[j];
          if (m + ngw < NTOK) {
#pragma unroll
              for (int j = 0; j < 4; ++j) nx[j] = *(const f32x4*)(x + (size_t)(m + ngw) * DM + 4 * lane + 256 * j); }
          rms_row(v, g, lane); store_row_bf16(hn + (size_t)m * DM, v, lane); } }
}

__device__ __forceinline__ void hyena_taps(const DArgs& a, LAS unsigned char* lds, int vcu, int G) {
    const int tid = opaque_tid();
    const float* hd = (const float*)(a.ws + WS_HDN); const float* w3 = a.in<18>();
    float* taps = (float*)(a.ws + WS_TAPS); float* nrm = (float*)(a.ws + WS_NRM);
    LAS float* hs = (LAS float*)lds;
    LAS float* tl = hs + 1024;
    const float dmin = -3.0701134573253944f, dmax = -15.350567286626972f;
    float wa[64], wb[64];
#pragma unroll
    for (int j = 0; j < 64; ++j) { wa[j] = w3[j * 1024 + tid]; wb[j] = w3[j * 1024 + 512 + tid]; }
    const float delta = fabsf(dmin + (float)tid * ((dmax - dmin) / 511.0f));
    for (int it = vcu; it < SEQ / 16; it += G) {
        const int t0 = it * 16;
        __syncthreads();
        for (int i = tid; i < 1024; i += NTHR) hs[i] = hd[t0 * 64 + i];
        __syncthreads();
        float nacc = 0.f;
#pragma unroll 1
        for (int tt = 0; tt < 16; ++tt) { float f = 0.f, b = 0.f;
#pragma unroll
            for (int j4 = 0; j4 < 16; ++j4) { const f32x4 h = *(const LAS f32x4*)(hs + tt * 64 + 4 * j4);
                f += h.x * wa[4 * j4] + h.y * wa[4 * j4 + 1] + h.z * wa[4 * j4 + 2] + h.w * wa[4 * j4 + 3];
                b += h.x * wb[4 * j4] + h.y * wb[4 * j4 + 1] + h.z * wb[4 * j4 + 2] + h.w * wb[4 * j4 + 3]; }
            const int t = t0 + tt; const float dec = __expf(-((float)t / (float)(SEQ - 1)) * delta); f *= dec; b *= dec;
            nacc += (t == 0) ? fabsf(f + b) : (fabsf(f) + fabsf(b));
            tl[tid * 17 + tt] = f; tl[(512 + tid) * 17 + tt] = b; }
        nrm[it * 512 + tid] = nacc;
        __syncthreads();
        for (int i = tid; i < 4096; i += NTHR) { const int n = i >> 2, q4 = i & 3; const LAS float* sp = tl + n * 17 + q4 * 4;
            *(f32x4*)(taps + (size_t)n * SEQ + t0 + q4 * 4) = (f32x4){sp[0], sp[1], sp[2], sp[3]}; }
    }
    __syncthreads();
}

__device__ __forceinline__ void qk_norm_rope_row(bf16* p, const u32x4 w0, const u32x4 w1, const float* g, const f32x4 c0, const f32x4 c1, const f32x4 s0, const f32x4 s1, bool rope, float sc) {
    float v[16];
    v[0] = bflo(w0.x); v[1] = bfhi(w0.x); v[2] = bflo(w0.y); v[3] = bfhi(w0.y); v[4] = bflo(w0.z); v[5] = bfhi(w0.z); v[6] = bflo(w0.w); v[7] = bfhi(w0.w);
    v[8] = bflo(w1.x); v[9] = bfhi(w1.x); v[10] = bflo(w1.y); v[11] = bfhi(w1.y); v[12] = bflo(w1.z); v[13] = bfhi(w1.z); v[14] = bflo(w1.w); v[15] = bfhi(w1.w);
    float ss = 0.f;
#pragma unroll
    for (int i = 0; i < 16; ++i) ss += v[i] * v[i];
    ss = quad_sum(ss);
    const float rstd = __frsqrt_rn(ss * (1.f / 64.f) + EPS);
#pragma unroll
    for (int i = 0; i < 16; ++i) v[i] = v[i] * rstd * g[i];
    if (rope) { const float cc[8] = {c0.x, c0.y, c0.z, c0.w, c1.x, c1.y, c1.z, c1.w}, sn[8] = {s0.x, s0.y, s0.z, s0.w, s1.x, s1.y, s1.z, s1.w};
#pragma unroll
        for (int i = 0; i < 8; ++i) { const float x1 = v[i], x2 = v[8 + i]; v[i] = x1 * cc[i] - x2 * sn[i]; v[8 + i] = x2 * cc[i] + x1 * sn[i]; } }
    u32x4 o0, o1;
    o0.x = pk2(v[0] * sc, v[1] * sc); o0.y = pk2(v[2] * sc, v[3] * sc); o0.z = pk2(v[4] * sc, v[5] * sc); o0.w = pk2(v[6] * sc, v[7] * sc);
    o1.x = pk2(v[8] * sc, v[9] * sc); o1.y = pk2(v[10] * sc, v[11] * sc); o1.z = pk2(v[12] * sc, v[13] * sc); o1.w = pk2(v[14] * sc, v[15] * sc);
    *(u32x4*)p = o0; *(u32x4*)(p + 8) = o1;
}
__device__ __forceinline__ void phase_prep_mix0(const DArgs& a, LAS unsigned char* lds, int vcu, int G) {
    const int tid = opaque_tid(), lane = tid & 63, wave = tid >> 6;
    const int gw = vcu * NWAVES + wave, ngw = G * NWAVES;
    bf16* U = (bf16*)(a.ws + WS_U);
    const float* ct = (const float*)(a.ws + WS_ROPE); const float* st = ct + SEQ * 8;
    { const float* cw = a.in<11>(); const float* cb = a.in<12>();
      bf16* zt = (bf16*)(a.ws + WS_ZT);
      LAS float* tile = (LAS float*)(lds + wave * 16640);
      const int sl = lane >> 3, cg = lane & 7;
      if ((ngw & 7) == 0) {
          const int c = (gw & 7) * 64 + cg * 8;
          float wx[3][8], wv[3][8], bx[8], bv[8];
#pragma unroll
          for (int i = 0; i < 8; ++i) { bx[i] = cb[512 + c + i]; bv[i] = cb[1024 + c + i];
#pragma unroll
              for (int j = 0; j < 3; ++j) { wx[j][i] = cw[j * 1536 + 512 + c + i]; wv[j][i] = cw[j * 1536 + 1024 + c + i]; } }
          for (int it = gw; it < BATCH * 64 * 8; it += ngw) {
              const int b = it >> 9, stile = (it >> 3) & 63, s0 = stile * 64, c0 = (it & 7) * 64;
#pragma unroll 4
              for (int k = 0; k < 8; ++k) { const int s = s0 + 8 * k + sl;
                  float zx[8], zv[8];
#pragma unroll
                  for (int i = 0; i < 8; ++i) { zx[i] = bx[i]; zv[i] = bv[i]; }
#pragma unroll
                  for (int j = 0; j < 3; ++j) { const int sp = s + j - 1;
                      if (sp >= 0 && sp < SEQ) { const bf16* row = U + (size_t)(b * SEQ + sp) * NU + 1536;
                          const u32x4 xw = *(const u32x4*)(row + 512 + c), vw = *(const u32x4*)(row + 1024 + c);
                          const float xs[8] = {bflo(xw.x), bfhi(xw.x), bflo(xw.y), bfhi(xw.y), bflo(xw.z), bfhi(xw.z), bflo(xw.w), bfhi(xw.w)};
                          const float vs[8] = {bflo(vw.x), bfhi(vw.x), bflo(vw.y), bfhi(vw.y), bflo(vw.z), bfhi(vw.z), bflo(vw.w), bfhi(vw.w)};
#pragma unroll
                          for (int i = 0; i < 8; ++i) { zx[i] += xs[i] * wx[j][i]; zv[i] += vs[i] * wv[j][i]; } } }
#pragma unroll
                  for (int i = 0; i < 8; ++i) tile[(cg * 8 + i) * 65 + 8 * k + sl] = zx[i] * zv[i]; }
              LDS_WAIT(); asm volatile("" ::: "memory");
#pragma unroll 2
              for (int k = 0; k < 8; ++k) { const int cc = 8 * k + sl; const LAS float* tr = tile + cc * 65 + cg * 8;
                  u32x4 w; w.x = pk2(tr[0], tr[1]); w.y = pk2(tr[2], tr[3]); w.z = pk2(tr[4], tr[5]); w.w = pk2(tr[6], tr[7]);
                  *(u32x4*)(zt + ((size_t)(b * 512 + c0 + cc)) * SEQ + s0 + cg * 8) = w; }
              LDS_WAIT(); asm volatile("" ::: "memory");
          }
      }
    }
    __syncthreads();
}

namespace att {
using f32x16 = __attribute__((ext_vector_type(16))) float;
using s16x4  = __attribute__((ext_vector_type(4))) short;
constexpr int KVBLK = 64, QBLK = 32;
constexpr int SHM_V = KVBLK * 128 * 2, SHM_K = KVBLK * 128 * 2;

constexpr float THR = 8.f;
#define KSWZ(row, colB) ((row) * 256 + ((colB) ^ (((row) & 7) << 4)))
#define SBAR() __builtin_amdgcn_sched_barrier(0)
__device__ __forceinline__ int crow(int r, int hi) { return (r & 3) + 8 * (r >> 2) + 4 * hi; }
__device__ __forceinline__ unsigned cvtpk(float lo, float hi) { unsigned r; asm volatile("v_cvt_pk_bf16_f32 %0, %1, %2" : "=v"(r) : "v"(lo), "v"(hi)); return r; }
typedef __bf16 bf16x2_t __attribute__((ext_vector_type(2)));
__device__ __forceinline__ float dot_ones(unsigned w, float acc) { return __builtin_amdgcn_fdot2_f32_bf16(__builtin_bit_cast(bf16x2_t, w), __builtin_bit_cast(bf16x2_t, 0x3f803f80u), acc, false); }
template <bool SHIFT> __device__ __forceinline__ void partialSM(f32x16& p0, float sh) {
  if (SHIFT) {
#pragma unroll
    for (int r = 0; r < 16; ++r) p0[r] += sh; }
#pragma unroll
  for (int r = 0; r < 16; ++r) p0[r] = __builtin_amdgcn_exp2f(p0[r]);
}
template <bool SHIFT> __device__ __forceinline__ void finishSM(f32x16& p0, f32x16& p1, float sh, float& l_reg, bf16x8& pa0, bf16x8& pa1, bf16x8& pa2, bf16x8& pa3) {
  if (SHIFT) {
#pragma unroll
    for (int r = 0; r < 16; ++r) p1[r] += sh; }
#pragma unroll
  for (int r = 0; r < 16; ++r) p1[r] = __builtin_amdgcn_exp2f(p1[r]);
#define PK4(P, BASE, OUT) do { u32x4 w = {cvtpk(P[BASE + 0], P[BASE + 1]), cvtpk(P[BASE + 2], P[BASE + 3]), cvtpk(P[BASE + 4], P[BASE + 5]), cvtpk(P[BASE + 6], P[BASE + 7])}; \
    OUT = *reinterpret_cast<bf16x8*>(&w); } while (0)
  PK4(p0, 0, pa0); PK4(p0, 8, pa1); PK4(p1, 0, pa2); PK4(p1, 8, pa3);
#undef PK4
  float ps0 = 0.f, ps1 = 0.f;
  { const u32x4 q0 = *reinterpret_cast<const u32x4*>(&pa0), q1 = *reinterpret_cast<const u32x4*>(&pa1), q2 = *reinterpret_cast<const u32x4*>(&pa2), q3 = *reinterpret_cast<const u32x4*>(&pa3);
    ps0 = dot_ones(q0.x, ps0); ps1 = dot_ones(q0.y, ps1); ps0 = dot_ones(q0.z, ps0); ps1 = dot_ones(q0.w, ps1);
    ps0 = dot_ones(q1.x, ps0); ps1 = dot_ones(q1.y, ps1); ps0 = dot_ones(q1.z, ps0); ps1 = dot_ones(q1.w, ps1);
    ps0 = dot_ones(q2.x, ps0); ps1 = dot_ones(q2.y, ps1); ps0 = dot_ones(q2.z, ps0); ps1 = dot_ones(q2.w, ps1);
    ps0 = dot_ones(q3.x, ps0); ps1 = dot_ones(q3.y, ps1); ps0 = dot_ones(q3.z, ps0); ps1 = dot_ones(q3.w, ps1); }
  l_reg += ps0 + ps1;
}
__device__ __forceinline__ void qkt(f32x16& p0, f32x16& p1, const char* Ks, const bf16x8* qr, int r32, int hi, int cbase) {
  p0 = f32x16{}; p1 = f32x16{};
#pragma unroll
  for (int d0 = 0; d0 < 4; ++d0) { const int cb = cbase + (d0 * 16 + hi * 8) * 2;
    bf16x8 b0 = *reinterpret_cast<const bf16x8*>(Ks + KSWZ(r32, cb));
    bf16x8 b1 = *reinterpret_cast<const bf16x8*>(Ks + KSWZ(32 + r32, cb));
    p0 = __builtin_amdgcn_mfma_f32_32x32x16_bf16(b0, qr[d0], p0, 0, 0, 0);
    p1 = __builtin_amdgcn_mfma_f32_32x32x16_bf16(b1, qr[d0], p1, 0, 0, 0); }
}
__device__ __forceinline__ int v_st(int k, int c) { const int kk = (k & ~0xC) | ((k & 4) << 1) | ((k & 8) >> 1); return ((kk >> 3) * 4 + (c >> 5)) * 512 + ((kk & 7) * 32 + (c & 31)) * 2; }
__device__ __forceinline__ int v_rd_base(int lane) { return ((lane & 3) << 3) | (((lane >> 2) & 3) << 6) | (((lane >> 4) & 1) << 5) | (((lane >> 5) & 1) << 8); }
constexpr int v_rd_off(int d0, int ks, int half) { return d0 * 512 + ks * 4096 + half * 2048; }
template <int OFF> __device__ __forceinline__ s16x4 tr_read(int vb) {
  s16x4 r; asm volatile("ds_read_b64_tr_b16 %0, %1 offset:%2" : "=&v"(r) : "v"(vb), "i"(OFF) : "memory"); return r;
}
#define PVG_RD(G, A, B, C, D) do { A = tr_read<v_rd_off((G) >> 1, ((G) & 1) * 2, 0)>(vb); B = tr_read<v_rd_off((G) >> 1, ((G) & 1) * 2, 1)>(vb); \
    C = tr_read<v_rd_off((G) >> 1, ((G) & 1) * 2 + 1, 0)>(vb); D = tr_read<v_rd_off((G) >> 1, ((G) & 1) * 2 + 1, 1)>(vb); } while (0)
#define PVG_MM(G, A, B, C, D) do { __builtin_amdgcn_s_setprio(1); o[(G) >> 1] = __builtin_amdgcn_mfma_f32_32x32x16_bf16(((G) & 1) ? pa2 : pa0, PVPK(A, B), o[(G) >> 1], 0, 0, 0); \
    o[(G) >> 1] = __builtin_amdgcn_mfma_f32_32x32x16_bf16(((G) & 1) ? pa3 : pa1, PVPK(C, D), o[(G) >> 1], 0, 0, 0); __builtin_amdgcn_s_setprio(0); } while (0)
#define PVPK(L, H) (bf16x8){L[0], L[1], L[2], L[3], H[0], H[1], H[2], H[3]}
#define PV_W4() do { asm volatile("s_waitcnt lgkmcnt(4)" ::: "memory"); SBAR(); } while (0)
#define PV_W0() do { asm volatile("s_waitcnt lgkmcnt(0)" ::: "memory"); SBAR(); } while (0)
#define PV_PRE(vb_) do { const int vb = (vb_); PVG_RD(0, va0, va1, va2, va3); PVG_RD(1, vb0_, vb1_, vb2_, vb3_); } while (0)
__device__ __forceinline__ void pv_d0(f32x16* o, int vb, bf16x8 pa0, bf16x8 pa1, bf16x8 pa2, bf16x8 pa3, s16x4 a0, s16x4 a1, s16x4 a2, s16x4 a3, s16x4 b0, s16x4 b1, s16x4 b2, s16x4 b3) {
  asm volatile("s_waitcnt lgkmcnt(0)" ::: "memory"); SBAR();
  PVG_MM(0, a0, a1, a2, a3); PVG_RD(2, a0, a1, a2, a3);
  PVG_MM(1, b0, b1, b2, b3); PVG_RD(3, b0, b1, b2, b3);
  PV_W4(); PVG_MM(2, a0, a1, a2, a3); PVG_RD(4, a0, a1, a2, a3);
  PV_W4(); PVG_MM(3, b0, b1, b2, b3); PVG_RD(5, b0, b1, b2, b3);
  PV_W4(); PVG_MM(4, a0, a1, a2, a3); PVG_RD(6, a0, a1, a2, a3);
  PV_W4(); PVG_MM(5, b0, b1, b2, b3); PVG_RD(7, b0, b1, b2, b3);
  PV_W4(); PVG_MM(6, a0, a1, a2, a3);
  PV_W0(); PVG_MM(7, b0, b1, b2, b3);
}
#undef PVG_MM
#undef PVPK
#undef PV_W4
#undef PV_W0
__device__ __forceinline__ void glds16(const void* gsrc, unsigned lds_dst) { unsigned keep;
  asm volatile("s_mov_b32 %0, m0\n\ts_mov_b32 m0, %2\n\ts_nop 0\n\tglobal_load_lds_dwordx4 %1, off\n\ts_mov_b32 m0, %0" : "=&s"(keep) : "v"(gsrc), "s"(lds_dst) : "memory"); }
#define WAIT_BAR(N) asm volatile("s_waitcnt vmcnt(" #N ") lgkmcnt(0)\n\ts_barrier" ::: "memory")
constexpr int RING_K = 0, RING_V = 3 * SHM_K, OFF_WS2 = 3 * SHM_K + 3 * SHM_V, OFF_O2B = 0;
template <bool SHIFT> __device__ __forceinline__ void attn_unit(const bf16* __restrict__ Qb, const bf16* __restrict__ Kh, const bf16* __restrict__ Vh, bf16* __restrict__ Ob, float lam, float negM2, const float* __restrict__ subln, char* lds) {
  const int tid = opaque_tid(), wid = __builtin_amdgcn_readfirstlane(tid >> 6), lane = tid & 63, r32 = lane & 31, hi = lane >> 5, comp = wid >> 2, wq = wid & 3;
  const unsigned lds0 = (unsigned)(uintptr_t)lds;
  float* ws = (float*)(lds + OFF_WS2) + wid * 64; float* li_l = ws;
  float l_reg = 0; f32x16 o[4] = {}; bf16x8 qr[4];
  const float sh = __builtin_bit_cast(float, __builtin_amdgcn_readfirstlane(__builtin_bit_cast(int, negM2)));
  unsigned ksrc[2], vsrc[2];
#pragma unroll
  for (int i = 0; i < 2; ++i) { const int pc = wid * 2 + i;
    { const int row = 4 * pc + (lane >> 4), c = (lane & 15) ^ (row & 7); ksrc[i] = (unsigned)(row * NU + c * 8); }
    { const int st = 2 * pc + (lane >> 5), k = (st >> 2) * 8 + ((lane & 31) >> 2), c = (st & 3) * 32 + 8 * (lane & 3); vsrc[i] = (unsigned)(k * NU + c); } }
  const unsigned kdst = lds0 + RING_K + wid * 2048, vdst = lds0 + RING_V + wid * 2048;
#define DMA_K(t, slot) do { glds16(Kh + (long)(t) * KVBLK * NU + ksrc[0], (unsigned)__builtin_amdgcn_readfirstlane(kdst + (slot))); glds16(Kh + (long)(t) * KVBLK * NU + ksrc[1], (unsigned)__builtin_amdgcn_readfirstlane(kdst + (slot) + 1024)); } while (0)
#define DMA_V(t, slot) do { glds16(Vh + (long)(t) * KVBLK * NU + vsrc[0], (unsigned)__builtin_amdgcn_readfirstlane(vdst + (slot))); glds16(Vh + (long)(t) * KVBLK * NU + vsrc[1], (unsigned)__builtin_amdgcn_readfirstlane(vdst + (slot) + 1024)); } while (0)
  DMA_K(0, 0); DMA_V(0, 0); DMA_K(1, SHM_K);
  const bf16* Qw = Qb + (long)(wq * QBLK + r32) * NU + comp * 64 + hi * 8;
#pragma unroll
  for (int d0 = 0; d0 < 4; ++d0) qr[d0] = *reinterpret_cast<const bf16x8*>(Qw + d0 * 16);
  const int cbase = comp * 128;
  const int vb0 = (int)(lds0 + RING_V) + v_rd_base(lane);
  const char* Kring = lds + RING_K;
  f32x16 pA0, pA1, pB0, pB1; bf16x8 pa0, pa1, pa2, pa3; constexpr int NT = SEQ / KVBLK;
  asm volatile("s_waitcnt vmcnt(0)" ::: "memory");
  __builtin_amdgcn_s_barrier();
  DMA_K(2, 2 * SHM_K); DMA_V(1, SHM_V);
  qkt(pA0, pA1, Kring, qr, r32, hi, cbase);
  WAIT_BAR(4);
  int kc = SHM_K, kn2 = 0, vp = 0, vn2 = 2 * SHM_V;
#define ROT3(x) ((x) == 2 * SHM_K ? 0 : (x) + SHM_K)
  s16x4 va0, va1, va2, va3, vb0_, vb1_, vb2_, vb3_;
#define STEP(PX0, PX1, PY0, PY1, j) do { \
    PV_PRE(vb0 + vp); \
    if ((j) + 2 < NT) DMA_K((j) + 2, kn2); if ((j) + 1 < NT) DMA_V((j) + 1, vn2); \
    partialSM<SHIFT>(PY0, sh); SBAR();                      \
    qkt(PX0, PX1, Kring + kc, qr, r32, hi, cbase); \
    finishSM<SHIFT>(PY0, PY1, sh, l_reg, pa0, pa1, pa2, pa3); SBAR(); \
    pv_d0(o, vb0 + vp, pa0, pa1, pa2, pa3, va0, va1, va2, va3, vb0_, vb1_, vb2_, vb3_); \
    if ((j) + 2 < NT) { WAIT_BAR(4); } else if ((j) + 1 < NT) { WAIT_BAR(2); } else { WAIT_BAR(0); } \
    kc = ROT3(kc); kn2 = ROT3(kn2); vp = ROT3(vp); vn2 = ROT3(vn2); } while (0)
  for (int j = 1; j + 1 < NT; j += 2) { STEP(pB0, pB1, pA0, pA1, j); STEP(pA0, pA1, pB0, pB1, j + 1); }
  STEP(pB0, pB1, pA0, pA1, NT - 1);
  PV_PRE(vb0 + vp);
  partialSM<SHIFT>(pB0, sh);
  finishSM<SHIFT>(pB0, pB1, sh, l_reg, pa0, pa1, pa2, pa3); SBAR();
  pv_d0(o, vb0 + vp, pa0, pa1, pa2, pa3, va0, va1, va2, va3, vb0_, vb1_, vb2_, vb3_);
  { auto rr = __builtin_amdgcn_permlane32_swap(__float_as_uint(l_reg), __float_as_uint(l_reg), false, false); l_reg = __uint_as_float(rr[0]) + __uint_as_float(rr[1]); }
  if (hi == 0) li_l[r32] = l_reg; asm volatile("s_waitcnt lgkmcnt(0)" ::: "memory");
  float rli[16];
#pragma unroll
  for (int r = 0; r < 16; ++r) rli[r] = __builtin_amdgcn_rcpf(li_l[crow(r, hi)]);
  float* O2 = (float*)(lds + OFF_O2B) + wq * 32 * 128;
  __syncthreads();
  if (comp == 1) {
#pragma unroll
    for (int r = 0; r < 16; ++r)
#pragma unroll
      for (int d0 = 0; d0 < 4; ++d0) O2[crow(r, hi) * 128 + d0 * 32 + r32] = o[d0][r] * rli[r];
  }
  __syncthreads();
  if (comp == 0) {
    float ss[16];
#pragma unroll
    for (int r = 0; r < 16; ++r) { float acc = 0.f;
#pragma unroll
      for (int d0 = 0; d0 < 4; ++d0) { const float d = o[d0][r] * rli[r] - lam * O2[crow(r, hi) * 128 + d0 * 32 + r32]; o[d0][r] = d; acc += d * d; }
      ss[r] = acc; }
#pragma unroll
    for (int r = 0; r < 16; ++r) { float v = row16_sum(ss[r]); v += __shfl_xor(v, 16);
      ss[r] = __frsqrt_rn(v * (1.f / 128.f) + EPS) * 0.8f; }
    bf16* Ow = Ob + (long)(wq * QBLK) * DM;
#pragma unroll
    for (int r = 0; r < 16; ++r) { const int orow = crow(r, hi);
#pragma unroll
      for (int d0 = 0; d0 < 4; ++d0) Ow[(long)orow * DM + d0 * 32 + r32] = (bf16)(pk2(o[d0][r] * ss[r] * subln[d0 * 32 + r32], 0.f) & 0xffffu); }
  }
  asm volatile("s_waitcnt vmcnt(0)" ::: "memory");
  __syncthreads();
#undef DMA_K
#undef PVG_RD
#undef PV_PRE
#undef DMA_V
#undef ROT3
#undef STEP
}
#undef WAIT_BAR
#undef KSWZ
#undef SBAR
}


namespace fft {
__device__ __forceinline__ int pad(int n) { return n + (n >> 4); }
constexpr int BUF_BYTES = (8192 + 512) * 8;
__device__ __forceinline__ f32x2 cmul(f32x2 a, f32x2 b) { return (f32x2){a.x * b.x - a.y * b.y, a.x * b.y + a.y * b.x}; }
__device__ __forceinline__ f32x2 cis_rev(float rev) { return (f32x2){__builtin_amdgcn_cosf(rev), __builtin_amdgcn_sinf(rev)}; }
#define FFT_DFT4(x0, x1, x2, x3, y0, y1, y2, y3) do { const f32x2 s02 = x0 + x2, d02 = x0 - x2, s13 = x1 + x3, d13 = x1 - x3; \
    y0 = s02 + s13; y2 = s02 - s13; y1 = (f32x2){d02.x + d13.y, d02.y - d13.x}; y3 = (f32x2){d02.x - d13.y, d02.y + d13.x}; } while (0)
__device__ __forceinline__ void dft16(f32x2 (&u)[16]) {
    f32x2 w[16];
#pragma unroll
    for (int a = 0; a < 4; ++a) FFT_DFT4(u[a], u[a + 4], u[a + 8], u[a + 12], w[a], w[a + 4], w[a + 8], w[a + 12]);
    const float c1 = 0.9238795325112867f, s1 = 0.3826834323650898f, r2 = 0.7071067811865476f;
    w[5]  = cmul(w[5],  (f32x2){c1, -s1});
    w[9]  = cmul(w[9],  (f32x2){r2, -r2});
    w[13] = cmul(w[13], (f32x2){s1, -c1});
    w[6]  = cmul(w[6],  (f32x2){r2, -r2});
    w[10] = (f32x2){w[10].y, -w[10].x};
    w[14] = cmul(w[14], (f32x2){-r2, -r2});
    w[7]  = cmul(w[7],  (f32x2){s1, -c1});
    w[11] = cmul(w[11], (f32x2){-r2, -r2});
    w[15] = cmul(w[15], (f32x2){-c1, s1});
#pragma unroll
    for (int b = 0; b < 4; ++b) FFT_DFT4(w[4 * b], w[4 * b + 1], w[4 * b + 2], w[4 * b + 3], u[b], u[b + 4], u[b + 8], u[b + 12]);
}
template <int P, bool LOAD>
__device__ __forceinline__ void pass16(f32x2 (&u)[16], LAS f32x2* buf, int tid) {
    if (LOAD) { const LAS f32x2* bp = buf + pad(tid);
#pragma unroll
        for (int r = 0; r < 16; ++r) u[r] = bp[544 * r];
    }
    const int k = tid & (P - 1);
    if (P > 1) {
        const float rev = -(float)k * (1.0f / (16.0f * P));
        const f32x2 w1 = cis_rev(rev), w2 = cis_rev(2.f * rev), w4 = cis_rev(4.f * rev), w8 = cis_rev(8.f * rev);
        const f32x2 w3 = cmul(w1, w2), w5 = cmul(w4, w1), w6 = cmul(w4, w2), w7 = cmul(w4, w3);
        u[1] = cmul(u[1], w1); u[2] = cmul(u[2], w2); u[3] = cmul(u[3], w3); u[4] = cmul(u[4], w4); u[5] = cmul(u[5], w5); u[6] = cmul(u[6], w6); u[7] = cmul(u[7], w7);
        u[8] = cmul(u[8], w8); u[9] = cmul(u[9], cmul(w8, w1)); u[10] = cmul(u[10], cmul(w8, w2)); u[11] = cmul(u[11], cmul(w8, w3)); u[12] = cmul(u[12], cmul(w8, w4));
        u[13] = cmul(u[13], cmul(w8, w5)); u[14] = cmul(u[14], cmul(w8, w6)); u[15] = cmul(u[15], cmul(w8, w7));
    }
    dft16(u);
    if (LOAD) __syncthreads();
    const int j = (tid - k) * 16 + k;
    LAS f32x2* sp = buf + j + (tid - k) + (k >> 4);
    constexpr int MS = (P == 1) ? 1 : (P == 16) ? 17 : 272;
#pragma unroll
    for (int m = 0; m < 16; ++m) sp[MS * m] = u[m];
    __syncthreads();
}
__device__ __forceinline__ void pass2_final(f32x2 (&lo)[8], f32x2 (&hi)[8], const LAS f32x2* buf, int tid) {
    const LAS f32x2* bp = buf + pad(tid);
#pragma unroll
    for (int q = 0; q < 8; ++q) { const int i = tid + 512 * q; const f32x2 u0 = bp[544 * q], u1 = cmul(bp[544 * (q + 8)], cis_rev(-(float)i * (1.0f / 8192.0f)));
        lo[q] = u0 + u1; hi[q] = u0 - u1; }
}
__device__ __forceinline__ void fft8192(f32x2 (&u)[16], LAS f32x2* buf, int tid) {
    pass16<1, false>(u, buf, tid); pass16<16, true>(u, buf, tid); pass16<256, true>(u, buf, tid);
    f32x2 lo[8], hi[8]; pass2_final(lo, hi, buf, tid);
#pragma unroll
    for (int q = 0; q < 8; ++q) { u[q] = lo[q]; u[q + 8] = hi[q]; }
    __syncthreads();
}
}

__device__ __forceinline__ void phase_attn(const DArgs& a, char* lds, int vcu, int G) {
    const int lane = opaque_tid() & 63;
    const bf16* U = (const bf16*)(a.ws + WS_U); bf16* A2 = (bf16*)(a.ws + WS_HN);
    float lam;
    { const float* lq1 = a.in<6>(); const float* lk1 = a.in<7>(); const float* lq2 = a.in<8>(); const float* lk2 = a.in<9>();
      const float p1 = wave_sum(lq1[lane] * lk1[lane]), p2 = wave_sum(lq2[lane] * lk2[lane]); lam = __expf(p1) - __expf(p2) + 0.2f; }
    const float* subln = a.in<10>();
    float negM2;
    { const float* qn = a.in<4>(); const float* kn = a.in<5>(); float gq = fabsf(qn[lane]), gk = fabsf(kn[lane]);
#pragma unroll
      for (int o = 1; o < 64; o <<= 1) { gq = fmaxf(gq, __shfl_xor(gq, o)); gk = fmaxf(gk, __shfl_xor(gk, o)); }
      negM2 = -8.0f * gq * gk * 1.4426950408889634f; if (negM2 > -64.f) negM2 = 0.f; }
    for (int u = vcu; u < BATCH * 4 * 32; u += G) {
        const int qb = u & 31, h = (u >> 5) & 3, b = u >> 7;
        const bf16* rowb = U + (size_t)b * SEQ * NU;
        if (negM2 == 0.f) att::attn_unit<false>(rowb + (size_t)(qb * 128) * NU + h * 128, rowb + 512 + h * 128, rowb + 1024 + h * 128, A2 + (size_t)(b * SEQ + qb * 128) * DM + h * 128, lam, negM2, subln, lds);
        else att::attn_unit<true>(rowb + (size_t)(qb * 128) * NU + h * 128, rowb + 512 + h * 128, rowb + 1024 + h * 128, A2 + (size_t)(b * SEQ + qb * 128) * DM + h * 128, lam, negM2, subln, lds);
    }
}
__device__ __forceinline__ void phase_hyena_fft(const DArgs& a, LAS unsigned char* lds, int vcu, int G) {
    const int tid = opaque_tid();
    const bf16* zt = (const bf16*)(a.ws + WS_ZT); bf16* yt = (bf16*)(a.ws + WS_YT); const f32x2* Kf = (const f32x2*)(a.ws + WS_KF);
    LAS f32x2* buf = (LAS f32x2*)lds;
    unsigned* ctr = (unsigned*)(a.ws + WS_CTL) + CW_FFT; LAS int* nxt = (LAS int*)(lds + fft::BUF_BYTES + 128);
    const int nst = ((2048 / G) * 3) / 4, nstatic = nst * G;
    int k = 0;
    bf16 zr0[8], zr1[8];
#define FFT_ZLOAD(IT) do { const int c_ = (IT) >> 2, bp_ = (IT) & 3; const bf16* z0_ = zt + ((size_t)((2 * bp_) * 512 + c_)) * SEQ; const bf16* z1_ = zt + ((size_t)((2 * bp_ + 1) * 512 + c_)) * SEQ; \
        _Pragma("unroll") for (int r = 0; r < 8; ++r) { zr0[r] = z0_[tid + 512 * r]; zr1[r] = z1_[tid + 512 * r]; } } while (0)
    if (vcu < 2048) FFT_ZLOAD(vcu);
    for (int it = vcu; it < 2048; ++k) {
        int claim = 0;
        if (tid == 0) claim = (k + 1 < nst) ? vcu + (k + 1) * G : nstatic + (int)__hip_atomic_fetch_add(ctr, 1u, __ATOMIC_RELAXED, __HIP_MEMORY_SCOPE_AGENT);
        const int c = it >> 2, bp = it & 3;
        f32x2 u[16];
        const f32x2* kf = Kf + (size_t)c * 8192;
#pragma unroll
        for (int r = 0; r < 8; ++r) { u[r] = (f32x2){bf2f(zr0[r]), bf2f(zr1[r])}; u[r + 8] = (f32x2){0.f, 0.f}; }
        fft::fft8192(u, buf, tid);
        if (tid == 0) *nxt = claim;
#pragma unroll
        for (int r = 0; r < 16; ++r) { const f32x2 y = fft::cmul(u[r], kf[tid + 512 * r]); u[r] = (f32x2){y.x, -y.y}; }
        fft::pass16<1, false>(u, buf, tid);
        const int itn = __builtin_amdgcn_readfirstlane(*nxt);
        if (itn < 2048) FFT_ZLOAD(itn);
        fft::pass16<16, true>(u, buf, tid); fft::pass16<256, true>(u, buf, tid);
        bf16* y0 = yt + ((size_t)((2 * bp) * 512 + c)) * SEQ; bf16* y1 = yt + ((size_t)((2 * bp + 1) * 512 + c)) * SEQ;
        const LAS f32x2* lp = buf + fft::pad(tid);
#pragma unroll
        for (int q = 0; q < 8; ++q) { const int i = tid + 512 * q; const f32x2 u0 = lp[544 * q], u1 = fft::cmul(lp[544 * (q + 8)], fft::cis_rev(-(float)i * (1.0f / 8192.0f)));
            const f32x2 rres = u0 + u1; y0[i] = (bf16)f2bf(rres.x * (1.0f / 8192.0f)); y1[i] = (bf16)f2bf(-rres.y * (1.0f / 8192.0f)); }
        __syncthreads();
        it = itn;
    }
#undef FFT_ZLOAD
}
__device__ __forceinline__ void phase_hyena_kf(const DArgs& a, LAS unsigned char* lds, int vcu, int G) {
    const int tid = opaque_tid();
    const float* tf = (const float*)(a.ws + WS_TAPS); const float* tb = tf + 512 * SEQ; f32x2* Kf = (f32x2*)(a.ws + WS_KF);
    LAS f32x2* buf = (LAS f32x2*)lds;
    const float* nrm = (const float*)(a.ws + WS_NRM);
    LAS float* red = (LAS float*)(lds + fft::BUF_BYTES);
    for (int c = vcu; c < 512; c += G) {
        float part = (tid < SEQ / 16) ? nrm[tid * 512 + c] : 0.f;
        part = wave_sum(part);
        if ((tid & 63) == 0) red[tid >> 6] = part;
        __syncthreads();
        const float sc = 1.f / (((red[0] + red[1]) + (red[2] + red[3])) + EPS);
        f32x2 u[16];
#pragma unroll
        for (int r = 0; r < 8; ++r) { const int n0 = tid + 512 * r; float v = tf[c * SEQ + n0]; if (n0 == 0) v += tb[c * SEQ]; u[r] = (f32x2){v * sc, 0.f};
            const int n = 4096 + n0; u[r + 8] = (f32x2){(n == 4096) ? 0.f : tb[c * SEQ + 8192 - n] * sc, 0.f}; }
        fft::fft8192(u, buf, tid);
#pragma unroll
        for (int r = 0; r < 16; ++r) Kf[(size_t)c * 8192 + tid + 512 * r] = u[r];
    }
}

__device__ __forceinline__ void phase_post_mix0(const DArgs& a, LAS unsigned char* lds, int vcu, int G) {
    const int tid = opaque_tid(), lane = tid & 63, wave = tid >> 6;
    const int gw = vcu * NWAVES + wave, ngw = G * NWAVES;
    bf16* A2 = (bf16*)(a.ws + WS_HN);
    const bf16* U = (const bf16*)(a.ws + WS_U); const bf16* yt = (const bf16*)(a.ws + WS_YT);
    const float* cw = a.in<11>(); const float* cb = a.in<12>(); const float* skip = a.in<19>();
    LAS float* tile = (LAS float*)(lds + wave * 16640);
    const int sl = lane >> 3, cg = lane & 7;
    const int c = (gw & 7) * 64 + cg * 8;
    float w1[3][8], wx[3][8], wv[3][8], b1[8], bx[8], bv[8], sk[8];
#pragma unroll
    for (int i = 0; i < 8; ++i) { b1[i] = cb[c + i]; bx[i] = cb[512 + c + i]; bv[i] = cb[1024 + c + i]; sk[i] = skip[c + i];
#pragma unroll
        for (int j = 0; j < 3; ++j) { w1[j][i] = cw[j * 1536 + c + i]; wx[j][i] = cw[j * 1536 + 512 + c + i]; wv[j][i] = cw[j * 1536 + 1024 + c + i]; } }
    for (int it = gw; it < BATCH * 64 * 8; it += ngw) {
        const int b = it >> 9, stile = (it >> 3) & 63, s0 = stile * 64, c0 = (it & 7) * 64;
#pragma unroll 4
        for (int k = 0; k < 8; ++k) { const int cc = 8 * k + sl; const u32x4 w = *(const u32x4*)(yt + ((size_t)(b * 512 + c0 + cc)) * SEQ + s0 + cg * 8);
            LAS float* tr = tile + cc * 65 + cg * 8; tr[0] = bflo(w.x); tr[1] = bfhi(w.x); tr[2] = bflo(w.y); tr[3] = bfhi(w.y); tr[4] = bflo(w.z); tr[5] = bfhi(w.z); tr[6] = bflo(w.w); tr[7] = bfhi(w.w); }
        LDS_WAIT(); asm volatile("" ::: "memory");
#pragma unroll 4
        for (int k = 0; k < 8; ++k) { const int s = s0 + 8 * k + sl;
            float x1[8], zx[8], zv[8];
#pragma unroll
            for (int i = 0; i < 8; ++i) { x1[i] = b1[i]; zx[i] = bx[i]; zv[i] = bv[i]; }
#pragma unroll
            for (int j = 0; j < 3; ++j) { const int sp = s + j - 1;
                if (sp >= 0 && sp < SEQ) { const bf16* row = U + (size_t)(b * SEQ + sp) * NU + 1536;
                    const u32x4 aw = *(const u32x4*)(row + c), xw = *(const u32x4*)(row + 512 + c), vw = *(const u32x4*)(row + 1024 + c);
                    const float as[8] = {bflo(aw.x), bfhi(aw.x), bflo(aw.y), bfhi(aw.y), bflo(aw.z), bfhi(aw.z), bflo(aw.w), bfhi(aw.w)};
                    const float xs[8] = {bflo(xw.x), bfhi(xw.x), bflo(xw.y), bfhi(xw.y), bflo(xw.z), bfhi(xw.z), bflo(xw.w), bfhi(xw.w)};
                    const float vs[8] = {bflo(vw.x), bfhi(vw.x), bflo(vw.y), bfhi(vw.y), bflo(vw.z), bfhi(vw.z), bflo(vw.w), bfhi(vw.w)};
#pragma unroll
                    for (int i = 0; i < 8; ++i) { x1[i] += as[i] * w1[j][i]; zx[i] += xs[i] * wx[j][i]; zv[i] += vs[i] * wv[j][i]; } } }
            float r[8];
#pragma unroll
            for (int i = 0; i < 8; ++i) { const float y = tile[(cg * 8 + i) * 65 + 8 * k + sl]; r[i] = (y + zx[i] * zv[i] * sk[i]) * x1[i]; }
            u32x4 o; o.x = pk2(r[0], r[1]); o.y = pk2(r[2], r[3]); o.z = pk2(r[4], r[5]); o.w = pk2(r[6], r[7]);
            *(u32x4*)(A2 + (size_t)(b * SEQ + s) * DM + 512 + c) = o; }
        LDS_WAIT(); asm volatile("" ::: "memory");
    }
    __syncthreads();
}

__device__ __forceinline__ void phase_router(const DArgs& a, LAS unsigned char* lds, int layer, int vcu, int G) {
    const int tid = opaque_tid(), lane = tid & 63, wave = tid >> 6;
    constexpr int WP = 1032;
    LAS bf16* WH = (LAS bf16*)lds;
    LAS bf16* WL = WH + 36 * WP;
    LAS float* LG = (LAS float*)lds + wave * (16 * 37);
    LAS float* GNl = (LAS float*)(lds + 2 * 36 * WP * 2);
    LAS int* eidl = (LAS int*)(GNl + 1024);
    LAS float* gatel = (LAS float*)(eidl + 256);
    LAS int* rankl = (LAS int*)(gatel + 256);
    LAS int* basel = rankl + 256;
    LAS int* cntl = basel + 32;
    LAS float* BE = (LAS float*)(cntl + 32);
    const float* wg = a.in<27>() + (size_t)layer * 1024 * 4; const float* bg = a.in<28>() + layer * 4;
    const float* we = a.in<29>() + (size_t)layer * 1024 * 32; const float* be = a.in<30>() + layer * 32;
    const float* gn = a.in<2>() + layer * 1024;
    const bf16* xin = (const bf16*)(a.ws + WS_XB); bf16* hn = (bf16*)(a.ws + WS_HN);
    unsigned* cursor = (unsigned*)(a.ws + WS_CTL) + (layer ? CW_CUR1 : CW_CUR0);
    int* rinfo = (int*)(a.ws + WS_RINFO);
    const float bg0 = bg[0], bg1 = bg[1], bg2 = bg[2], bg3 = bg[3];
    const unsigned* otc = (const unsigned*)(a.ws + WS_CTL) + (layer ? CW_OPT1 : CW_OPT0);
    for (int blk = vcu; blk < NTOK / 128; blk += G) {
        for (int i = tid; i < 512 * 8; i += NTHR) { const int q = i & 7, kp = i >> 3;
            const f32x4 w0 = *(const f32x4*)(we + (size_t)(2 * kp) * 32 + 4 * q) * gn[2 * kp], w1 = *(const f32x4*)(we + (size_t)(2 * kp + 1) * 32 + 4 * q) * gn[2 * kp + 1];
#pragma unroll
            for (int j = 0; j < 4; ++j) { const unsigned h = pk2(w0[j], w1[j]); const unsigned l = pk2(w0[j] - bflo(h), w1[j] - bfhi(h));
                *(LAS unsigned*)(WH + (4 + 4 * q + j) * WP + 2 * kp) = h; *(LAS unsigned*)(WL + (4 + 4 * q + j) * WP + 2 * kp) = l; } }
        { const int kp = tid; const f32x4 w0 = *(const f32x4*)(wg + (size_t)(2 * kp) * 4) * gn[2 * kp], w1 = *(const f32x4*)(wg + (size_t)(2 * kp + 1) * 4) * gn[2 * kp + 1];
            GNl[2 * kp] = gn[2 * kp]; GNl[2 * kp + 1] = gn[2 * kp + 1];
#pragma unroll
            for (int j = 0; j < 4; ++j) { const unsigned h = pk2(w0[j], w1[j]); const unsigned l = pk2(w0[j] - bflo(h), w1[j] - bfhi(h));
                *(LAS unsigned*)(WH + j * WP + 2 * kp) = h; *(LAS unsigned*)(WL + j * WP + 2 * kp) = l; } }
        if (tid < 32) { BE[tid] = be[tid]; cntl[tid] = 0; }
        if (tid < 64) { unsigned polls = 0;
            while ((unsigned)__builtin_amdgcn_readfirstlane(__hip_atomic_load(otc + (blk >> 1), __ATOMIC_RELAXED, __HIP_MEMORY_SCOPE_AGENT)) < 32u) { __builtin_amdgcn_s_sleep(2); if (++polls > (1u << 22)) break; }
            __builtin_amdgcn_fence(__ATOMIC_ACQUIRE, "agent");
            asm volatile("s_waitcnt vmcnt(0)" ::: "memory"); }
        __syncthreads();
        const int t = lane & 15, kg = lane >> 4; const int m = blk * 128 + wave * 16 + t;
        const bf16* xrow = xin + (size_t)m * DM + 8 * kg; bf16* hrow = hn + (size_t)m * DM + 8 * kg;
        float ss = 0.f;
#pragma unroll 8
        for (int sI = 0; sI < 32; ++sI) { const u32x4 xw = *(const u32x4*)(xrow + 32 * sI);
            const float v0 = bflo(xw.x), v1 = bfhi(xw.x), v2 = bflo(xw.y), v3 = bfhi(xw.y), v4 = bflo(xw.z), v5 = bfhi(xw.z), v6 = bflo(xw.w), v7 = bfhi(xw.w);
            ss += (v0 * v0 + v1 * v1) + (v2 * v2 + v3 * v3) + (v4 * v4 + v5 * v5) + (v6 * v6 + v7 * v7); }
        { auto rr = __builtin_amdgcn_permlane16_swap(__float_as_uint(ss), __float_as_uint(ss), false, false); ss = __uint_as_float(rr[0]) + __uint_as_float(rr[1]); }
        { auto rr = __builtin_amdgcn_permlane32_swap(__float_as_uint(ss), __float_as_uint(ss), false, false); ss = __uint_as_float(rr[0]) + __uint_as_float(rr[1]); }
        const float rstd = __frsqrt_rn(ss * (1.f / DM) + EPS);
        f32x4 acc0 = {0.f, 0.f, 0.f, 0.f}, acc1 = acc0, acc2 = acc0;
        const int r0 = t, r1 = 16 + t, r2 = (32 + t) < 36 ? 32 + t : 35;
        const LAS bf16* bh0 = WH + r0 * WP + 8 * kg; const LAS bf16* bh1 = WH + r1 * WP + 8 * kg; const LAS bf16* bh2 = WH + r2 * WP + 8 * kg;
        constexpr int LO = 36 * WP;
        u32x4 xa[8], xb[8];
#pragma unroll
        for (int i = 0; i < 8; ++i) xa[i] = *(const u32x4*)(xrow + 32 * i);
#pragma unroll
        for (int c = 0; c < 4; ++c) {
            if (c < 3) {
#pragma unroll
                for (int i = 0; i < 8; ++i) xb[i] = *(const u32x4*)(xrow + 32 * (8 * (c + 1) + i)); }
#pragma unroll
            for (int i = 0; i < 8; ++i) { const int sI = 8 * c + i; const u32x4 xw = xa[i];
                const bf16x8 ax = *reinterpret_cast<const bf16x8*>(&xw);
                { const bf16x8 bh = *(const LAS bf16x8*)(bh0 + 32 * sI), bl = *(const LAS bf16x8*)(bh0 + LO + 32 * sI);
                  acc0 = __builtin_amdgcn_mfma_f32_16x16x32_bf16(ax, bh, acc0, 0, 0, 0); acc0 = __builtin_amdgcn_mfma_f32_16x16x32_bf16(ax, bl, acc0, 0, 0, 0); }
                { const bf16x8 bh = *(const LAS bf16x8*)(bh1 + 32 * sI), bl = *(const LAS bf16x8*)(bh1 + LO + 32 * sI);
                  acc1 = __builtin_amdgcn_mfma_f32_16x16x32_bf16(ax, bh, acc1, 0, 0, 0); acc1 = __builtin_amdgcn_mfma_f32_16x16x32_bf16(ax, bl, acc1, 0, 0, 0); }
                { const bf16x8 bh = *(const LAS bf16x8*)(bh2 + 32 * sI), bl = *(const LAS bf16x8*)(bh2 + LO + 32 * sI);
                  acc2 = __builtin_amdgcn_mfma_f32_16x16x32_bf16(ax, bh, acc2, 0, 0, 0); acc2 = __builtin_amdgcn_mfma_f32_16x16x32_bf16(ax, bl, acc2, 0, 0, 0); }
                const f32x4 g0 = *(const LAS f32x4*)(GNl + 32 * sI + 8 * kg), g1 = *(const LAS f32x4*)(GNl + 32 * sI + 8 * kg + 4);
                u32x4 hw; hw.x = pk2(bflo(xw.x) * rstd * g0.x, bfhi(xw.x) * rstd * g0.y); hw.y = pk2(bflo(xw.y) * rstd * g0.z, bfhi(xw.y) * rstd * g0.w);
                hw.z = pk2(bflo(xw.z) * rstd * g1.x, bfhi(xw.z) * rstd * g1.y); hw.w = pk2(bflo(xw.w) * rstd * g1.z, bfhi(xw.w) * rstd * g1.w);
                *(u32x4*)(hrow + 32 * sI) = hw; }
            __builtin_amdgcn_sched_barrier(0);
#pragma unroll
            for (int i = 0; i < 8; ++i) xa[i] = xb[i];
        }
        __syncthreads();
#pragma unroll
        for (int r = 0; r < 4; ++r) { LAS float* lr = LG + (4 * kg + r) * 37; lr[t] = acc0[r]; lr[16 + t] = acc1[r]; if (t < 4) lr[32 + t] = acc2[r]; }
        LDS_WAIT(); asm volatile("" ::: "memory");
        { const LAS float* lr = LG + t * 37; const int tl = wave * 16 + t;
            float gl[4] = {lr[0] * rstd + bg0, lr[1] * rstd + bg1, lr[2] * rstd + bg2, lr[3] * rstd + bg3};
            int gi = 0; float gm = gl[0];
#pragma unroll
            for (int n = 1; n < 4; ++n) if (gl[n] > gm) { gm = gl[n]; gi = n; }
            float gs = 0.f;
#pragma unroll
            for (int n = 0; n < 4; ++n) gs += __expf(gl[n] - gm);
            const float gwt = 1.f / gs;
            float el[8];
#pragma unroll
            for (int n = 0; n < 8; ++n) el[n] = lr[4 + gi * 8 + n] * rstd + BE[gi * 8 + n];
            int e1 = 0; float m1 = el[0];
#pragma unroll
            for (int n = 1; n < 8; ++n) if (el[n] > m1) { m1 = el[n]; e1 = n; }
            int e2 = -1; float m2 = -3.0e38f;
#pragma unroll
            for (int n = 0; n < 8; ++n) if (n != e1 && el[n] > m2) { m2 = el[n]; e2 = n; }
            const float p2 = __expf(m2 - m1), inv = 1.f / (1.f + p2);
            if (kg == 0) { eidl[2 * tl] = gi * 8 + e1; eidl[2 * tl + 1] = gi * 8 + e2; gatel[2 * tl] = gwt * inv; gatel[2 * tl + 1] = gwt * p2 * inv; } }
        __syncthreads();
        if (tid < 256) rankl[tid] = __hip_atomic_fetch_add(cntl + eidl[tid], 1, __ATOMIC_RELAXED, __HIP_MEMORY_SCOPE_WORKGROUP);
        __syncthreads();
        if (tid < 32) { int tq = tid; asm volatile("" : "+v"(tq));
            const int cnt = cntl[tq]; basel[tq] = cnt ? (int)atomicAdd(&cursor[tq], (unsigned)cnt) : 0; cntl[tq] = 0; }
        __syncthreads();
        if (tid < 256) { const int e = eidl[tid], pos = basel[e] + rankl[tid]; int* ri = rinfo + ((size_t)e * MOE_CAP + pos) * 2;
            ri[0] = (blk * 128) * 2 + tid; ri[1] = __builtin_bit_cast(int, gatel[tid]); }
        __syncthreads();
    }
}

__device__ __forceinline__ void phase_moe_gemm(const DArgs& a, LAS unsigned char* lds, int layer, int which, int G) {
    LAS int* tpre = (LAS int*)(lds + 131072 + 1024); LAS int* cntl = tpre + 64;
    const int* cnt = (const int*)((unsigned*)(a.ws + WS_CTL) + (layer ? CW_CUR1 : CW_CUR0));
    LAS int* xe = tpre + 40;
    if (threadIdx.x < 64) { const int lane = threadIdx.x;
        const int c = lane < 32 ? (int)__hip_atomic_load(cnt + lane, __ATOMIC_RELAXED, __HIP_MEMORY_SCOPE_AGENT) : 0; const int nt = (c + 255) >> 8;
        int p = nt;
        for (int d = 1; d < 32; d <<= 1) { const int o = __shfl_up(p, d); if (lane >= d) p += o; }
        int rk = 0;
#pragma unroll
        for (int i = 0; i < 32; ++i) { const int ni = __builtin_amdgcn_readlane(nt, i); rk += (ni > nt || (ni == nt && i < lane)) ? 1 : 0; }
        if (lane < 32) { cntl[lane] = c; tpre[lane + 1] = p;
            const int xr = rk < 8 ? rk : rk < 16 ? 15 - rk : rk < 24 ? rk - 16 : 31 - rk;
            if (xr == ((int)blockIdx.x & 7)) xe[rk >> 3] = lane; }
        if (lane == 0) tpre[0] = 0; }
    __syncthreads();
    pg8::MoeSched S; S.tpre = tpre; S.cnt = cntl; S.xe = xe; S.rinfo = (const int*)(a.ws + WS_RINFO); S.G = G; S.c = (int)blockIdx.x; S.ntiles = __builtin_amdgcn_readfirstlane(tpre[32]);
    S.tcnt = (unsigned*)(a.ws + WS_CTL) + (layer ? CW_TCNT1 : CW_TCNT0); S.mode = which + 1;
    if (which == 0) { S.A = (const char*)(a.ws + WS_HN); S.W = (const char*)(a.ws + WS_W13); S.K = 1024; S.wstride_e = (size_t)1024 * 1024 * 2; S.gather = true;
        pg8::EpiSwiGLU E{(bf16*)(a.ws + WS_HID)};
        pg8::gemm_phase<pg8::EpiSwiGLU, pg8::MoeSched, true>(lds, 1024, S, E); }
    else { S.A = (const char*)(a.ws + WS_HID); S.W = (const char*)(a.ws + WS_W2); S.K = 512; S.wstride_e = (size_t)1024 * 512 * 2; S.gather = false;
        pg8::EpiMoeOut E{(bf16*)(a.ws + WS_Y)};
        pg8::gemm_phase<pg8::EpiMoeOut, pg8::MoeSched, false>(lds, 512, S, E); }
}

__device__ __forceinline__ void phase_prep1(const DArgs& a, LAS unsigned char* lds, int vcu, int G) {
    const int tid = opaque_tid(), lane = tid & 63, wave = tid >> 6;
    const int gw = vcu * NWAVES + wave, ngw = G * NWAVES;
    constexpr int WP = 1032;
    LAS bf16* WH = (LAS bf16*)lds; LAS bf16* WL = WH + 16 * WP; LAS float* RS = (LAS float*)(lds + 2 * 16 * WP * 2) + wave * 16;
    const float* win = a.in<21>(); const float* g = a.in<1>() + 1024;
    for (int i = tid; i < 512 * 4; i += NTHR) { const int q = i & 3, kp = i >> 2;
        const f32x4 w0 = *(const f32x4*)(win + (size_t)(2 * kp) * 3088 + 3072 + 4 * q) * g[2 * kp], w1 = *(const f32x4*)(win + (size_t)(2 * kp + 1) * 3088 + 3072 + 4 * q) * g[2 * kp + 1];
#pragma unroll
        for (int j = 0; j < 4; ++j) { const unsigned h = pk2(w0[j], w1[j]); const unsigned l = pk2(w0[j] - bflo(h), w1[j] - bfhi(h));
            *(LAS unsigned*)(WH + (4 * q + j) * WP + 2 * kp) = h; *(LAS unsigned*)(WL + (4 * q + j) * WP + 2 * kp) = l; } }
    __syncthreads();
    const float* gb = a.in<24>(); float* rstd1 = (float*)(a.ws + WS_RSTD1); float* gates = (float*)(a.ws + WS_GATES);
    const bf16* X1 = (const bf16*)(a.ws + WS_XB); const bf16* Y = (const bf16*)(a.ws + WS_Y); bf16* X2 = (bf16*)a.out;
    const int t = lane & 15, kg = lane >> 4;
    const LAS bf16* bhp = WH + t * WP + 8 * kg; constexpr int LO = 16 * WP;
    for (int grp = gw; grp < NTOK / 16; grp += ngw) {
        const int m0 = grp * 16, m = m0 + t;
        const bf16* xrow = X1 + (size_t)m * DM + 8 * kg; const bf16* y0row = Y + (size_t)(2 * m) * DM + 8 * kg; const bf16* y1row = y0row + DM; bf16* orow = X2 + (size_t)m * DM + 8 * kg;
        u32x4 xa[4], ya[4], za[4], xb[4], yb[4], zb[4];
#pragma unroll
        for (int i = 0; i < 4; ++i) { xa[i] = *(const u32x4*)(xrow + 32 * i); ya[i] = *(const u32x4*)(y0row + 32 * i); za[i] = *(const u32x4*)(y1row + 32 * i); }
        float ss = 0.f; f32x4 acc = {0.f, 0.f, 0.f, 0.f};
#pragma unroll
        for (int c = 0; c < 8; ++c) {
            if (c < 7) {
#pragma unroll
                for (int i = 0; i < 4; ++i) { const int sn = 4 * (c + 1) + i; xb[i] = *(const u32x4*)(xrow + 32 * sn); yb[i] = *(const u32x4*)(y0row + 32 * sn); zb[i] = *(const u32x4*)(y1row + 32 * sn); } }
#pragma unroll
            for (int i = 0; i < 4; ++i) { const int sI = 4 * c + i; const u32x4 xw = xa[i], yw = ya[i], zw = za[i];
                const float v0 = bflo(xw.x) + bflo(yw.x) + bflo(zw.x), v1 = bfhi(xw.x) + bfhi(yw.x) + bfhi(zw.x), v2 = bflo(xw.y) + bflo(yw.y) + bflo(zw.y), v3 = bfhi(xw.y) + bfhi(yw.y) + bfhi(zw.y);
                const float v4 = bflo(xw.z) + bflo(yw.z) + bflo(zw.z), v5 = bfhi(xw.z) + bfhi(yw.z) + bfhi(zw.z), v6 = bflo(xw.w) + bflo(yw.w) + bflo(zw.w), v7 = bfhi(xw.w) + bfhi(yw.w) + bfhi(zw.w);
                ss += (v0 * v0 + v1 * v1) + (v2 * v2 + v3 * v3) + (v4 * v4 + v5 * v5) + (v6 * v6 + v7 * v7);
                u32x4 hw; hw.x = pk2(v0, v1); hw.y = pk2(v2, v3); hw.z = pk2(v4, v5); hw.w = pk2(v6, v7);
                *(u32x4*)(orow + 32 * sI) = hw;
                u32x4 lw; lw.x = pk2(v0 - bflo(hw.x), v1 - bfhi(hw.x)); lw.y = pk2(v2 - bflo(hw.y), v3 - bfhi(hw.y)); lw.z = pk2(v4 - bflo(hw.z), v5 - bfhi(hw.z)); lw.w = pk2(v6 - bflo(hw.w), v7 - bfhi(hw.w));
                const bf16x8 ah = *reinterpret_cast<const bf16x8*>(&hw), al = *reinterpret_cast<const bf16x8*>(&lw);
                const bf16x8 bh = *(const LAS bf16x8*)(bhp + 32 * sI), bl = *(const LAS bf16x8*)(bhp + LO + 32 * sI);
                acc = __builtin_amdgcn_mfma_f32_16x16x32_bf16(ah, bh, acc, 0, 0, 0); acc = __builtin_amdgcn_mfma_f32_16x16x32_bf16(al, bh, acc, 0, 0, 0); acc = __builtin_amdgcn_mfma_f32_16x16x32_bf16(ah, bl, acc, 0, 0, 0); }
            __builtin_amdgcn_sched_barrier(0);
#pragma unroll
            for (int i = 0; i < 4; ++i) { xa[i] = xb[i]; ya[i] = yb[i]; za[i] = zb[i]; }
        }
        { auto rr = __builtin_amdgcn_permlane16_swap(__float_as_uint(ss), __float_as_uint(ss), false, false); ss = __uint_as_float(rr[0]) + __uint_as_float(rr[1]); }
        { auto rr = __builtin_amdgcn_permlane32_swap(__float_as_uint(ss), __float_as_uint(ss), false, false); ss = __uint_as_float(rr[0]) + __uint_as_float(rr[1]); }
        const float rstd = __frsqrt_rn(ss * (1.f / DM) + EPS);
        if (kg == 0) { rstd1[m] = rstd; RS[t] = rstd; }
        LDS_WAIT(); asm volatile("" ::: "memory");
        { const float bias = gb[t]; const int type = t >> 2;
#pragma unroll
          for (int r = 0; r < 4; ++r) { float x = acc[r] * RS[4 * kg + r] + bias;
              if (type & 1) x = fminf(x, 0.f) - log1pf(__expf(-fabsf(x)));
              gates[(size_t)(m0 + 4 * kg + r) * 16 + t] = x; } }
        LDS_WAIT(); asm volatile("" ::: "memory");
    }
    __syncthreads();
    moe_convert_items(a, 1, (LAS float*)(lds + wave * 16384), gw, ngw, lane);
}


namespace ml {
using att::f32x16; using att::s16x4; using att::crow; using att::cvtpk; using att::tr_read; using att::v_rd_base;
constexpr int QS = 0, KS = 32768, KT = 65536, VS = 98304, AVS = 114688, CS = 131072, MISC = 147456;
constexpr int M_AL = MISC, M_TH = MISC + 512, M_QN = MISC + 1024, M_N = MISC + 1536, M_NP = MISC + 2048, M_SCR = MISC + 6144;
constexpr size_t WS_QC = WS_HN, WS_KC = WS_HN + 32 * MiB;
constexpr size_t WS_AL = WS_TAPS, WS_TH = WS_TAPS + 1 * MiB, WS_AP = WS_TAPS + 2 * MiB, WS_AM = WS_TAPS + 3 * MiB, WS_BL = WS_TAPS + 4 * MiB;
__device__ __forceinline__ int v_st2(int k, int c) { return ((k >> 3) * 2 + (c >> 5)) * 512 + ((k & 7) * 32 + (c & 31)) * 2; }
__device__ __forceinline__ int v_st4(int k, int c) { return ((k >> 3) * 4 + (c >> 5)) * 512 + ((k & 7) * 32 + (c & 31)) * 2; }
constexpr int rd2(int ks, int half) { return ks * 2048 + half * 1024; }
constexpr int rd4(int ks, int half) { return ks * 4096 + half * 2048; }
#define MLPK(L, H) (bf16x8){L[0], L[1], L[2], L[3], H[0], H[1], H[2], H[3]}
#define ML_WAIT() do { asm volatile("s_waitcnt lgkmcnt(0)" ::: "memory"); __builtin_amdgcn_sched_barrier(0); } while (0)
__device__ __forceinline__ void unpack8(const u32x4 w, float (&v)[8]) { v[0] = bflo(w.x); v[1] = bfhi(w.x); v[2] = bflo(w.y); v[3] = bfhi(w.y); v[4] = bflo(w.z); v[5] = bfhi(w.z); v[6] = bflo(w.w); v[7] = bfhi(w.w); }

__device__ __forceinline__ void mlstm_gate_stats(const DArgs& a, int vcu, int G) {
    const int tid = opaque_tid(), lane = tid & 63, wave = tid >> 6;
    const int gw = vcu * NWAVES + wave, ngw = G * NWAVES;
    const float* gates = (const float*)(a.ws + WS_GATES);
    for (int g = gw; g < 64 * 32; g += ngw) {
        const int sq = g >> 5, j = g & 31, h = sq & 3, dir = (sq >> 2) & 1, b = sq >> 3;
        const float* gb = gates + (size_t)b * SEQ * 16 + (dir * 2) * 4 + h;
        const int t0 = j * 128 + lane, t1 = t0 + 64; const int p0 = dir ? (SEQ - 1 - t0) : t0, p1 = dir ? (SEQ - 1 - t1) : t1;
        const float li0 = gb[(size_t)p0 * 16], lf0 = gb[(size_t)p0 * 16 + 4], li1 = gb[(size_t)p1 * 16], lf1 = gb[(size_t)p1 * 16 + 4];
        float x0 = lf0, x1 = lf1;
#pragma unroll
        for (int o = 1; o < 64; o <<= 1) { const float v0 = __shfl_up(x0, o), v1 = __shfl_up(x1, o); if (lane >= o) { x0 += v0; x1 += v1; } }
        x1 += __shfl(x0, 63);
        float amax = fmaxf(li0 - x0, li1 - x1);
#pragma unroll
        for (int o = 1; o < 64; o <<= 1) amax = fmaxf(amax, __shfl_xor(amax, o));
        if (lane == 63) { ((float*)(a.ws + WS_AM))[g] = amax; ((float*)(a.ws + WS_BL))[g] = x1; }
    }
}

__device__ __forceinline__ void phase_mlstm_pre(const DArgs& a, int vcu, int G) {
    const int tid = opaque_tid(), lane = tid & 63, wave = tid >> 6;
    const int gw = vcu * NWAVES + wave, ngw = G * NWAVES;
    const bf16* U = (const bf16*)(a.ws + WS_U); const float* gates = (const float*)(a.ws + WS_GATES);
    const float* cw = a.in<22>(); const float* cb = a.in<23>();
    for (int g = gw; g < 64 * 32; g += ngw) {
        const int sq = g >> 5, j = g & 31, h = sq & 3, dir = (sq >> 2) & 1, b = sq >> 3;
        const float* gb = gates + (size_t)b * SEQ * 16 + (dir * 2) * 4 + h;
        const float* AM = (const float*)(a.ws + WS_AM) + sq * 32; const float* BL = (const float*)(a.ws + WS_BL) + sq * 32;
        const float am = AM[lane & 31], bl = BL[lane & 31];
        float m = 0.f, Mc = 0.f, ap = 0.f;
        for (int jj = 0; jj < 32; ++jj) { const float amj = __shfl(am, jj), blj = __shfl(bl, jj); const float M2 = fmaxf(m, amj);
            if (jj == j) { Mc = M2; ap = __expf(m - M2); } m = blj + M2; }
        const int t0 = j * 128 + lane, t1 = t0 + 64; const int p0 = dir ? (SEQ - 1 - t0) : t0, p1 = dir ? (SEQ - 1 - t1) : t1;
        const float li0 = gb[(size_t)p0 * 16], lf0 = gb[(size_t)p0 * 16 + 4], li1 = gb[(size_t)p1 * 16], lf1 = gb[(size_t)p1 * 16 + 4];
        float x0 = lf0, x1 = lf1;
#pragma unroll
        for (int o = 1; o < 64; o <<= 1) { const float v0 = __shfl_up(x0, o), v1 = __shfl_up(x1, o); if (lane >= o) { x0 += v0; x1 += v1; } }
        x1 += __shfl(x0, 63);
        float* AL = (float*)(a.ws + WS_AL) + (size_t)sq * SEQ; float* TH = (float*)(a.ws + WS_TH) + (size_t)sq * SEQ; float* AP = (float*)(a.ws + WS_AP) + sq * 32;
        AL[t0] = __expf(li0 - x0 - Mc); AL[t1] = __expf(li1 - x1 - Mc); TH[t0] = __expf(-x0 - Mc); TH[t1] = __expf(-x1 - Mc);
        if (lane == 0) AP[j] = ap;
    }
    bf16* QC = (bf16*)(a.ws + WS_QC); bf16* KC = (bf16*)(a.ws + WS_KC);
    float wq[3][8], wk[3][8], bq[8], bk[8];
#pragma unroll
    for (int j = 0; j < 8; ++j) { bq[j] = cb[8 * lane + j]; bk[j] = cb[512 + 8 * lane + j];
#pragma unroll
        for (int t = 0; t < 3; ++t) { wq[t][j] = cw[t * 1024 + 8 * lane + j]; wk[t][j] = cw[t * 1024 + 512 + 8 * lane + j]; } }
    const int hq = lane >> 4, dq = 8 * (lane & 15);
    for (int g = gw; g < NTOK / 8; g += ngw) {
        const int m0 = g * 8, b = m0 >> 12, s0 = m0 & (SEQ - 1);
        const bf16* base = U + (size_t)m0 * NU + 8 * lane;
        u32x4 qw[10], kw[10];
#pragma unroll
        for (int r = 0; r < 10; ++r) { const int s = s0 + r - 1;
            if (s >= 0 && s < SEQ) { qw[r] = *(const u32x4*)(base + (long)(r - 1) * NU); kw[r] = *(const u32x4*)(base + (long)(r - 1) * NU + 512); }
            else { qw[r] = (u32x4){0u, 0u, 0u, 0u}; kw[r] = qw[r]; } }
#pragma unroll
        for (int r = 0; r < 8; ++r) {
            const int s = s0 + r;
            float x0[8], x1[8], x2[8], oq[8], ok[8];
            unpack8(qw[r], x0); unpack8(qw[r + 1], x1); unpack8(qw[r + 2], x2);
#pragma unroll
            for (int j = 0; j < 8; ++j) oq[j] = siluf_(bq[j] + x0[j] * wq[0][j] + x1[j] * wq[1][j] + x2[j] * wq[2][j]) * 0.08838834764831845f;
            unpack8(kw[r], x0); unpack8(kw[r + 1], x1); unpack8(kw[r + 2], x2);
#pragma unroll
            for (int j = 0; j < 8; ++j) ok[j] = siluf_(bk[j] + x0[j] * wk[0][j] + x1[j] * wk[1][j] + x2[j] * wk[2][j]);
            u32x4 w; w.x = pk2(oq[0], oq[1]); w.y = pk2(oq[2], oq[3]); w.z = pk2(oq[4], oq[5]); w.w = pk2(oq[6], oq[7]);
            *(u32x4*)(QC + ((size_t)((b * 4 + hq) * SEQ + s)) * 128 + dq) = w;
            w.x = pk2(ok[0], ok[1]); w.y = pk2(ok[2], ok[3]); w.z = pk2(ok[4], ok[5]); w.w = pk2(ok[6], ok[7]);
            *(u32x4*)(KC + ((size_t)((b * 4 + hq) * SEQ + s)) * 128 + dq) = w;
        }
    }
}

__device__ __forceinline__ void phase_mlstm(const DArgs& a, LAS unsigned char* lds, int ldsb, int vcu, int G) {
    const int tid = opaque_tid(), wid = __builtin_amdgcn_readfirstlane(tid >> 6), lane = tid & 63, r32 = lane & 31, hi = lane >> 5;
    const int eh = wid >> 2, tb = eh ? 3 - (wid & 3) : (wid & 3), oi = wid & 3;
    const bool owner = tb <= 1;
    const bf16* U = (const bf16*)(a.ws + WS_U); const bf16* QC = (const bf16*)(a.ws + WS_QC); const bf16* KC = (const bf16*)(a.ws + WS_KC);
    LAS float* ALl = (LAS float*)(lds + M_AL); LAS float* THl = (LAS float*)(lds + M_TH); LAS float* QN = (LAS float*)(lds + M_QN); LAS float* NS = (LAS float*)(lds + M_N);
    LAS float* NP = (LAS float*)(lds + M_NP); LAS float* SCR = (LAS float*)(lds + M_SCR) + wid * 64;
    const int vbase = ldsb + v_rd_base(lane);
    const int vbC = vbase + CS + eh * 512, vbVe = vbase + VS + eh * 512, vbAV = vbase + VS, vbKT = vbase + KT + oi * 512;
    const int cvec = tid & 15, rowb = tid >> 4, vvec = tid & 7, vrow = tid >> 3;
    LAS unsigned char* cwb = lds + CS + (oi >> 1) * 8192 + (oi & 1) * 4096 + hi * 1024 + r32 * 2;
    for (int it = vcu; it < 256; it += G) {
        const int slice = it & 3, h = (it >> 2) & 3, dir = (it >> 4) & 1, b = it >> 5, sq = (b * 2 + dir) * 4 + h;
        for (int i = tid; i < 4096; i += NTHR) ((LAS unsigned*)(lds + CS))[i] = 0u;
        if (tid < 128) NS[tid] = 0.f;
        f32x16 Cacc0 = f32x16{}, Cacc1 = f32x16{};
        const bf16* qb = QC + (size_t)(b * 4 + h) * SEQ * 128; const bf16* kb = KC + (size_t)(b * 4 + h) * SEQ * 128;
        const bf16* vb = U + (size_t)b * SEQ * NU + 1024 + h * 256 + slice * 64;
        const float* AL = (const float*)(a.ws + WS_AL) + (size_t)sq * SEQ; const float* TH = (const float*)(a.ws + WS_TH) + (size_t)sq * SEQ; const float* AP = (const float*)(a.ws + WS_AP) + sq * 32;
        u32x4 rq[4], rk[4], rv[2]; float ralk[4], r_th = 0.f, r_ap;
#define ML_PREFETCH(CH) do { \
            _Pragma("unroll") for (int i = 0; i < 4; ++i) { const int tt = (CH) * 128 + rowb + 32 * i, p = dir ? (SEQ - 1 - tt) : tt; rq[i] = *(const u32x4*)(qb + (unsigned)(p * 128 + 8 * cvec)); rk[i] = *(const u32x4*)(kb + (unsigned)(p * 128 + 8 * cvec)); ralk[i] = AL[tt]; } \
            _Pragma("unroll") for (int i = 0; i < 2; ++i) { const int tt = (CH) * 128 + vrow + 64 * i, p = dir ? (SEQ - 1 - tt) : tt; rv[i] = *(const u32x4*)(vb + (unsigned)(p * NU + 8 * vvec)); } \
            if (tid < 128) { r_th = TH[(CH) * 128 + tid]; } r_ap = AP[(CH)]; } while (0)
        ML_PREFETCH(0);
        __syncthreads();
        for (int ch = 0; ch < SEQ / 128; ++ch) {
            const float a_prev = __builtin_bit_cast(float, __builtin_amdgcn_readfirstlane(__builtin_bit_cast(int, r_ap)));
            { float cs[8];
#pragma unroll
              for (int j = 0; j < 8; ++j) cs[j] = 0.f;
#pragma unroll
              for (int i = 0; i < 4; ++i) { const int t = rowb + 32 * i; const int ro = t * 256 + ((cvec * 16) ^ ((t & 7) << 4));
                  *(LAS u32x4*)(lds + QS + ro) = rq[i];
                  float kv[8]; unpack8(rk[i], kv); const float al = ralk[i];
#pragma unroll
                  for (int j = 0; j < 8; ++j) { kv[j] *= al; cs[j] += kv[j]; }
                  u32x4 w; w.x = pk2(kv[0], kv[1]); w.y = pk2(kv[2], kv[3]); w.z = pk2(kv[4], kv[5]); w.w = pk2(kv[6], kv[7]);
                  *(LAS u32x4*)(lds + KS + ro) = w; *(LAS u32x4*)(lds + KT + (t >> 6) * 16384 + v_st4(t & 63, 8 * cvec)) = w; }
#pragma unroll
              for (int j = 0; j < 8; ++j) {
                  { auto rr = __builtin_amdgcn_permlane16_swap(__float_as_uint(cs[j]), __float_as_uint(cs[j]), false, false); cs[j] = __uint_as_float(rr[0]) + __uint_as_float(rr[1]); }
                  { auto rr = __builtin_amdgcn_permlane32_swap(__float_as_uint(cs[j]), __float_as_uint(cs[j]), false, false); cs[j] = __uint_as_float(rr[0]) + __uint_as_float(rr[1]); } }
              if (lane < 16) { *(LAS f32x4*)(NP + wid * 128 + cvec * 8) = (f32x4){cs[0], cs[1], cs[2], cs[3]}; *(LAS f32x4*)(NP + wid * 128 + cvec * 8 + 4) = (f32x4){cs[4], cs[5], cs[6], cs[7]}; } }
#pragma unroll
            for (int i = 0; i < 2; ++i) { const int t = vrow + 64 * i; *(LAS u32x4*)(lds + VS + (t >> 6) * 8192 + v_st2(t & 63, 8 * vvec)) = rv[i]; }
            if (tid < 128) { THl[tid] = r_th; }
            __syncthreads();
            if (ch + 1 < SEQ / 128) ML_PREFETCH(ch + 1);
            s16x4 cl[8], chh[8];
#define ML_CRD(T, KS) do { cl[4 * (T) + (KS)] = tr_read<(T) * 8192 + rd2((KS), 0)>(vbC); chh[4 * (T) + (KS)] = tr_read<(T) * 8192 + rd2((KS), 1)>(vbC); } while (0)
            ML_CRD(0, 0); ML_CRD(0, 1); ML_CRD(0, 2); ML_CRD(0, 3); ML_CRD(1, 0); ML_CRD(1, 1); ML_CRD(1, 2); ML_CRD(1, 3);
#undef ML_CRD
            { const int t = tid >> 2, part = tid & 3; f32x2 d2 = {0.f, 0.f};
#pragma unroll
              for (int i = 0; i < 4; ++i) { const int c16 = part * 4 + i; float qv[8]; unpack8(*(const LAS u32x4*)(lds + QS + t * 256 + ((c16 * 16) ^ ((t & 7) << 4))), qv);
                  const f32x4 n0 = *(const LAS f32x4*)(NS + c16 * 8), n1 = *(const LAS f32x4*)(NS + c16 * 8 + 4);
                  d2 += (f32x2){qv[0], qv[1]} * (f32x2){n0.x, n0.y}; d2 += (f32x2){qv[2], qv[3]} * (f32x2){n0.z, n0.w}; d2 += (f32x2){qv[4], qv[5]} * (f32x2){n1.x, n1.y}; d2 += (f32x2){qv[6], qv[7]} * (f32x2){n1.z, n1.w}; }
              float d = quad_sum(d2.x + d2.y);
              if (part == 0) QN[t] = d;
            }
            bf16x8 qr[8];
            { const int row = 32 * tb + r32;
#pragma unroll
              for (int d0 = 0; d0 < 8; ++d0) qr[d0] = *(const LAS bf16x8*)(lds + QS + row * 256 + ((d0 * 32 + hi * 16) ^ ((row & 7) << 4))); }
            f32x16 o = f32x16{};
            ML_WAIT();
#pragma unroll
            for (int k8 = 0; k8 < 8; ++k8) o = __builtin_amdgcn_mfma_f32_32x32x16_bf16(qr[k8], MLPK(cl[k8], chh[k8]), o, 0, 0, 0);
#pragma unroll
            for (int r = 0; r < 16; ++r) o[r] *= a_prev;
            float ps = 0.f, ps2 = 0.f; f32x16 pA; s16x4 vr0, vr1, vr2, vr3; bf16x8 pa0, pa1;
#define ML_SP(SB, P) do { P = f32x16{}; const int rowk = 32 * (SB) + r32; \
              _Pragma("unroll") for (int d0 = 0; d0 < 8; ++d0) { const bf16x8 ka = *(const LAS bf16x8*)(lds + KS + rowk * 256 + ((d0 * 32 + hi * 16) ^ ((rowk & 7) << 4))); \
                  P = __builtin_amdgcn_mfma_f32_32x32x16_bf16(ka, qr[d0], P, 0, 0, 0); } } while (0)
#define ML_VRD(SB) do { vr0 = tr_read<((SB) >> 1) * 8192 + rd2(((SB) & 1) * 2, 0)>(vbVe); vr1 = tr_read<((SB) >> 1) * 8192 + rd2(((SB) & 1) * 2, 1)>(vbVe); \
              vr2 = tr_read<((SB) >> 1) * 8192 + rd2(((SB) & 1) * 2 + 1, 0)>(vbVe); vr3 = tr_read<((SB) >> 1) * 8192 + rd2(((SB) & 1) * 2 + 1, 1)>(vbVe); } while (0)
#define ML_PFIN(SB, P) do { if ((SB) == tb) { _Pragma("unroll") for (int r = 0; r < 16; ++r) if (crow(r, hi) > r32) P[r] = 0.f; } \
              { u32x4 w = {cvtpk(P[0], P[1]), cvtpk(P[2], P[3]), cvtpk(P[4], P[5]), cvtpk(P[6], P[7])}; pa0 = *reinterpret_cast<bf16x8*>(&w); \
                ps = att::dot_ones(w.x, ps); ps2 = att::dot_ones(w.y, ps2); ps = att::dot_ones(w.z, ps); ps2 = att::dot_ones(w.w, ps2); } \
              { u32x4 w = {cvtpk(P[8], P[9]), cvtpk(P[10], P[11]), cvtpk(P[12], P[13]), cvtpk(P[14], P[15])}; pa1 = *reinterpret_cast<bf16x8*>(&w); \
                ps = att::dot_ones(w.x, ps); ps2 = att::dot_ones(w.y, ps2); ps = att::dot_ones(w.z, ps); ps2 = att::dot_ones(w.w, ps2); } } while (0)
#define ML_PVM() do { o = __builtin_amdgcn_mfma_f32_32x32x16_bf16(pa0, MLPK(vr0, vr1), o, 0, 0, 0); o = __builtin_amdgcn_mfma_f32_32x32x16_bf16(pa1, MLPK(vr2, vr3), o, 0, 0, 0); } while (0)
            ML_SP(0, pA); ML_VRD(0); ML_PFIN(0, pA); ML_WAIT(); ML_PVM();
            if (tb >= 1) { ML_SP(1, pA); ML_VRD(1); ML_PFIN(1, pA); ML_WAIT(); ML_PVM();
                if (tb >= 2) { ML_SP(2, pA); ML_VRD(2); ML_PFIN(2, pA); ML_WAIT(); ML_PVM();
                    if (tb >= 3) { ML_SP(3, pA); ML_VRD(3); ML_PFIN(3, pA); ML_WAIT(); ML_PVM(); } } }
#undef ML_SP
#undef ML_VRD
#undef ML_PFIN
#undef ML_PVM
            ps += ps2;
            { auto rr = __builtin_amdgcn_permlane32_swap(__float_as_uint(ps), __float_as_uint(ps), false, false); ps = __uint_as_float(rr[0]) + __uint_as_float(rr[1]); }
            if (owner) {
#pragma unroll
                for (int r = 0; r < 16; ++r) { Cacc0[r] *= a_prev; Cacc1[r] *= a_prev; }
#define ML_ST(T) do { const s16x4 al_0 = tr_read<(T) * 16384 + rd4(0, 0)>(vbKT), ah_0 = tr_read<(T) * 16384 + rd4(0, 1)>(vbKT), al_1 = tr_read<(T) * 16384 + rd4(1, 0)>(vbKT), ah_1 = tr_read<(T) * 16384 + rd4(1, 1)>(vbKT); \
              const s16x4 al_2 = tr_read<(T) * 16384 + rd4(2, 0)>(vbKT), ah_2 = tr_read<(T) * 16384 + rd4(2, 1)>(vbKT), al_3 = tr_read<(T) * 16384 + rd4(3, 0)>(vbKT), ah_3 = tr_read<(T) * 16384 + rd4(3, 1)>(vbKT); \
              const s16x4 bl_0 = tr_read<(T) * 8192 + rd2(0, 0)>(vbAV), bh_0 = tr_read<(T) * 8192 + rd2(0, 1)>(vbAV), bl_1 = tr_read<(T) * 8192 + rd2(1, 0)>(vbAV), bh_1 = tr_read<(T) * 8192 + rd2(1, 1)>(vbAV); \
              const s16x4 bl_2 = tr_read<(T) * 8192 + rd2(2, 0)>(vbAV), bh_2 = tr_read<(T) * 8192 + rd2(2, 1)>(vbAV), bl_3 = tr_read<(T) * 8192 + rd2(3, 0)>(vbAV), bh_3 = tr_read<(T) * 8192 + rd2(3, 1)>(vbAV); \
              const s16x4 cl_0 = tr_read<(T) * 8192 + 512 + rd2(0, 0)>(vbAV), ch_0 = tr_read<(T) * 8192 + 512 + rd2(0, 1)>(vbAV), cl_1 = tr_read<(T) * 8192 + 512 + rd2(1, 0)>(vbAV), ch_1 = tr_read<(T) * 8192 + 512 + rd2(1, 1)>(vbAV); \
              const s16x4 cl_2 = tr_read<(T) * 8192 + 512 + rd2(2, 0)>(vbAV), ch_2 = tr_read<(T) * 8192 + 512 + rd2(2, 1)>(vbAV), cl_3 = tr_read<(T) * 8192 + 512 + rd2(3, 0)>(vbAV), ch_3 = tr_read<(T) * 8192 + 512 + rd2(3, 1)>(vbAV); \
              ML_WAIT(); \
              Cacc0 = __builtin_amdgcn_mfma_f32_32x32x16_bf16(MLPK(al_0, ah_0), MLPK(bl_0, bh_0), Cacc0, 0, 0, 0); Cacc1 = __builtin_amdgcn_mfma_f32_32x32x16_bf16(MLPK(al_0, ah_0), MLPK(cl_0, ch_0), Cacc1, 0, 0, 0); \
              Cacc0 = __builtin_amdgcn_mfma_f32_32x32x16_bf16(MLPK(al_1, ah_1), MLPK(bl_1, bh_1), Cacc0, 0, 0, 0); Cacc1 = __builtin_amdgcn_mfma_f32_32x32x16_bf16(MLPK(al_1, ah_1), MLPK(cl_1, ch_1), Cacc1, 0, 0, 0); \
              Cacc0 = __builtin_amdgcn_mfma_f32_32x32x16_bf16(MLPK(al_2, ah_2), MLPK(bl_2, bh_2), Cacc0, 0, 0, 0); Cacc1 = __builtin_amdgcn_mfma_f32_32x32x16_bf16(MLPK(al_2, ah_2), MLPK(cl_2, ch_2), Cacc1, 0, 0, 0); \
              Cacc0 = __builtin_amdgcn_mfma_f32_32x32x16_bf16(MLPK(al_3, ah_3), MLPK(bl_3, bh_3), Cacc0, 0, 0, 0); Cacc1 = __builtin_amdgcn_mfma_f32_32x32x16_bf16(MLPK(al_3, ah_3), MLPK(cl_3, ch_3), Cacc1, 0, 0, 0); } while (0)
                ML_ST(0); ML_ST(1);
#undef ML_ST
            }
            __syncthreads();
            { const float D = a_prev * QN[32 * tb + r32] + ps; const float dinv = __builtin_amdgcn_rcpf(fmaxf(fabsf(D), THl[32 * tb + r32]));
              if (hi == 0) SCR[r32] = dinv; asm volatile("s_waitcnt lgkmcnt(0)" ::: "memory");
              bf16* H = (bf16*)(a.ws + (dir ? WS_HB : WS_HF)) + (size_t)b * SEQ * DM + h * 256 + slice * 64 + eh * 32 + r32;
#pragma unroll
              for (int r = 0; r < 16; ++r) { const int t = ch * 128 + 32 * tb + crow(r, hi), p = dir ? (SEQ - 1 - t) : t; H[(size_t)p * DM] = (bf16)(pk2(o[r] * SCR[crow(r, hi)], 0.f) & 0xffffu); } }
            if (owner) {
#pragma unroll
                for (int r = 0; r < 16; r += 2) { const unsigned w0 = pk2(Cacc0[r], Cacc0[r + 1]), w1 = pk2(Cacc1[r], Cacc1[r + 1]);
                    LAS unsigned char* c0 = cwb + ((r >> 3) & 1) * 2048 + ((r & 3) + 4 * ((r >> 2) & 1)) * 64; LAS unsigned char* c1 = cwb + (((r + 1) >> 3) & 1) * 2048 + (((r + 1) & 3) + 4 * (((r + 1) >> 2) & 1)) * 64;
                    *(LAS bf16*)c0 = (bf16)(w0 & 0xffffu); *(LAS bf16*)c1 = (bf16)(w0 >> 16); *(LAS bf16*)(c0 + 512) = (bf16)(w1 & 0xffffu); *(LAS bf16*)(c1 + 512) = (bf16)(w1 >> 16); } }
            if (tid < 128) NS[tid] = a_prev * NS[tid] + (((NP[tid] + NP[128 + tid]) + (NP[256 + tid] + NP[384 + tid])) + ((NP[512 + tid] + NP[640 + tid]) + (NP[768 + tid] + NP[896 + tid])));
            __syncthreads();
        }
#undef ML_PREFETCH
    }
}
#undef MLPK
#undef ML_WAIT
}

__device__ __forceinline__ void phase_post_mix1(const DArgs& a, int vcu, int G) {
    const int tid = opaque_tid(), lane = tid & 63, wave = tid >> 6;
    const int gw = vcu * NWAVES + wave, ngw = G * NWAVES;
    const bf16* Hf = (const bf16*)(a.ws + WS_HF); const bf16* Hb = (const bf16*)(a.ws + WS_HB); const bf16* U = (const bf16*)(a.ws + WS_U);
    const float* on = a.in<25>(); bf16* A2 = (bf16*)(a.ws + WS_HN);
    float onr[16];
#pragma unroll
    for (int i = 0; i < 16; ++i) onr[i] = on[16 * lane + i];
    u32x4 nf[2], nb[2], no[2];
#pragma unroll
    for (int half = 0; half < 2; ++half) { const int col = 16 * lane + 8 * half; if (gw < NTOK) {
        nf[half] = *(const u32x4*)(Hf + (size_t)gw * DM + col); nb[half] = *(const u32x4*)(Hb + (size_t)gw * DM + col); no[half] = *(const u32x4*)(U + (size_t)gw * NU + 2048 + col); } }
    for (int m = gw; m < NTOK; m += ngw) {
        float v[16], o[16];
        u32x4 cf[2] = {nf[0], nf[1]}, cb[2] = {nb[0], nb[1]}, co[2] = {no[0], no[1]};
        if (m + ngw < NTOK) { const size_t mn = (size_t)(m + ngw);
#pragma unroll
            for (int half = 0; half < 2; ++half) { const int col = 16 * lane + 8 * half;
                nf[half] = *(const u32x4*)(Hf + mn * DM + col); nb[half] = *(const u32x4*)(Hb + mn * DM + col); no[half] = *(const u32x4*)(U + mn * NU + 2048 + col); } }
#pragma unroll
        for (int half = 0; half < 2; ++half) {
            const u32x4 f = cf[half], bk = cb[half], ow = co[half];
            v[8 * half + 0] = bflo(f.x) + bflo(bk.x); v[8 * half + 1] = bfhi(f.x) + bfhi(bk.x); v[8 * half + 2] = bflo(f.y) + bflo(bk.y); v[8 * half + 3] = bfhi(f.y) + bfhi(bk.y);
            v[8 * half + 4] = bflo(f.z) + bflo(bk.z); v[8 * half + 5] = bfhi(f.z) + bfhi(bk.z); v[8 * half + 6] = bflo(f.w) + bflo(bk.w); v[8 * half + 7] = bfhi(f.w) + bfhi(bk.w);
            o[8 * half + 0] = bflo(ow.x); o[8 * half + 1] = bfhi(ow.x); o[8 * half + 2] = bflo(ow.y); o[8 * half + 3] = bfhi(ow.y);
            o[8 * half + 4] = bflo(ow.z); o[8 * half + 5] = bfhi(ow.z); o[8 * half + 6] = bflo(ow.w); o[8 * half + 7] = bfhi(ow.w); }
        float ss = 0.f;
#pragma unroll
        for (int i = 0; i < 16; ++i) ss += v[i] * v[i];
        ss = row16_sum(ss);
        const float rstd = __frsqrt_rn(ss * (1.f / 256.f) + EPS);
        float r[16];
#pragma unroll
        for (int i = 0; i < 16; ++i) r[i] = v[i] * rstd * onr[i] * sigmoidf_(o[i]);
        u32x4 w0, w1; w0.x = pk2(r[0], r[1]); w0.y = pk2(r[2], r[3]); w0.z = pk2(r[4], r[5]); w0.w = pk2(r[6], r[7]);
        w1.x = pk2(r[8], r[9]); w1.y = pk2(r[10], r[11]); w1.z = pk2(r[12], r[13]); w1.w = pk2(r[14], r[15]);
        *(u32x4*)(A2 + (size_t)m * DM + 16 * lane) = w0; *(u32x4*)(A2 + (size_t)m * DM + 16 * lane + 8) = w1;
    }
}

#define XB_TMO      128
#define XB_XCNT(j)  (256  + 64 * (j))
#define XB_XSUB(j)  (1280 + 64 * (j))
#define XB_XGEN(j)  (2304 + 64 * (j))
#define XB_TOP      3328
#define XB_TOPGEN   3392
#define XCD_BAR_WORDS 3456
#define XB_SPIN_CAP (1u << 22)
constexpr int CW_BAR = 4096;
constexpr int LDS_CTL_OFF = LDS_BYTES - 256;
__device__ __forceinline__ unsigned xb_ld(unsigned* p)              { return __hip_atomic_load(p, __ATOMIC_RELAXED, __HIP_MEMORY_SCOPE_AGENT); }
__device__ __forceinline__ unsigned xb_add(unsigned* p, unsigned v) { return __hip_atomic_fetch_add(p, v, __ATOMIC_RELAXED, __HIP_MEMORY_SCOPE_AGENT); }
__device__ __forceinline__ unsigned xb_xcc_id() { return (unsigned)__builtin_amdgcn_s_getreg((3 << 11) | 20) & 0xFu; }
#define XB_SPIN(cond, bar) do { unsigned _sp = 0; while (cond) { __builtin_amdgcn_s_sleep(1); \
    if ((++_sp & 255u) == 0u) { if (xb_ld(&(bar)[XB_TMO])) break; if (_sp > XB_SPIN_CAP) { atomicAdd(&(bar)[XB_TMO], 1u); break; } } } } while (0)
struct XcdBarrier { unsigned* bar; unsigned x; volatile LAS unsigned* st; };
__device__ __forceinline__ XcdBarrier xcd_barrier_post(unsigned* bar, volatile LAS unsigned* st) {
    XcdBarrier b; b.bar = bar; b.x = xb_xcc_id(); b.st = st;
    if (threadIdx.x == 0) (void)xb_add(&bar[XB_XCNT(b.x)], 1u);
    return b;
}
__device__ __forceinline__ void xcd_barrier_complete(unsigned* bar, unsigned x, unsigned& nloc, unsigned& nx) {
    const unsigned G = gridDim.x * gridDim.y * gridDim.z;
    unsigned sum, cnt, mine, sp = 0u;
    for (;;) {
        sum = 0u; cnt = 0u; mine = 0u;
#pragma unroll
        for (unsigned j = 0; j < 16; ++j) { const unsigned c = xb_ld(&bar[XB_XCNT(j)]); sum += c; cnt += (c > 0u) ? 1u : 0u; mine = (j == x) ? c : mine; }
        if (sum == G) break;
        __builtin_amdgcn_s_sleep(1);
        if ((++sp & 255u) == 0u) { if (xb_ld(&bar[XB_TMO])) break; if (sp > XB_SPIN_CAP) { atomicAdd(&bar[XB_TMO], 1u); break; } }
    }
    nloc = mine > 0u ? mine : 1u; nx = cnt > 0u ? cnt : 1u;
}
__device__ __forceinline__ void xcd_barrier(const XcdBarrier& b) {
    asm volatile("s_waitcnt vmcnt(0)" ::: "memory");
    __syncthreads();
    if (threadIdx.x == 0) {
        unsigned* bar = b.bar;
        __builtin_amdgcn_s_waitcnt(0);
        unsigned nloc = b.st[0], nx = b.st[1];
        if (nloc == 0u) { xcd_barrier_complete(bar, b.x, nloc, nx); b.st[0] = nloc; b.st[1] = nx; }
        const unsigned old = xb_add(&bar[XB_XSUB(b.x)], 1u);
        const unsigned gen = old / nloc;
        if (old + 1u == (gen + 1u) * nloc) {
            __builtin_amdgcn_fence(__ATOMIC_RELEASE, "agent");
            asm volatile("s_waitcnt vmcnt(0)" ::: "memory");
            const unsigned og = xb_add(&bar[XB_TOP], 1u);
            const unsigned tg = og / nx;
            if (og + 1u == (tg + 1u) * nx) xb_add(&bar[XB_TOPGEN], 1u);
            else XB_SPIN(xb_ld(&bar[XB_TOPGEN]) == tg, bar);
            __builtin_amdgcn_fence(__ATOMIC_ACQUIRE, "agent");
            xb_add(&bar[XB_XGEN(b.x)], 1u);
            asm volatile("s_waitcnt vmcnt(0)" ::: "memory");
        } else {
            XB_SPIN(xb_ld(&bar[XB_XGEN(b.x)]) == gen, bar);
            __builtin_amdgcn_fence(__ATOMIC_ACQUIRE, "agent");
            asm volatile("s_waitcnt vmcnt(0)" ::: "memory");
        }
    }
    __syncthreads();
}

__global__ void __launch_bounds__(NTHR, 2) fwd_kernel(Args kargs) {
    extern __shared__ __attribute__((aligned(16))) unsigned char lds_raw[];
    DArgs args; args.ka = (const char*)__builtin_amdgcn_kernarg_segment_ptr(); args.out = kargs.out; args.ws = kargs.ws;
    LAS unsigned char* lds = (LAS unsigned char*)lds_raw;
    const int G = gridDim.x, bx = blockIdx.x;
    const int vcu = (G % 8 == 0) ? (bx % 8) * (G / 8) + bx / 8 : bx;
    const int lo = kargs.ph_lo, hi = kargs.ph_hi;
    unsigned char* ws = args.ws;
#define IN(k) (lo <= (k) && (k) < hi)
#if MK_ONE
    { volatile LAS unsigned* st = (volatile LAS unsigned*)(lds + LDS_CTL_OFF); if (threadIdx.x < 64) st[threadIdx.x] = 0u; }
    __syncthreads();
    XcdBarrier xbar = xcd_barrier_post((unsigned*)(ws + WS_CTL) + CW_BAR, (volatile LAS unsigned*)(lds + LDS_CTL_OFF));
#define SEAM(k) do { if ((k) + 1 < hi) xcd_barrier(xbar); } while (0)
#else
#define SEAM(k) do { __syncthreads(); } while (0)
#endif
    if (IN(0)) { phase_prep0(args, lds, vcu, G); SEAM(0); }
    if (IN(1)) { hyena_taps(args, lds, vcu, G);
        pg8::DenseSched S; S.init((const bf16*)(ws + WS_HN), (const bf16*)(ws + WS_WIN0), NTOK, NU, DM, G, bx);
        pg8::EpiQKV0 E{(bf16*)(ws + WS_U), NU, args.in<4>(), args.in<5>(), (const float*)(ws + WS_ROPE), (const float*)(ws + WS_ROPE) + SEQ * 8};
        pg8::gemm_phase<pg8::EpiQKV0, pg8::DenseSched, false>(lds, DM, S, E); SEAM(1); }
    if (IN(2)) { phase_prep_mix0(args, lds, vcu, G); phase_hyena_kf(args, lds, vcu, G); SEAM(2); }
    if (IN(3)) { phase_attn(args, (char*)lds_raw, vcu, G); phase_hyena_fft(args, lds, vcu, G); SEAM(3); }
    if (IN(4)) { phase_post_mix0(args, lds, vcu, G); SEAM(4); }
    if (IN(5)) { pg8::DenseSched S; S.init((const bf16*)(ws + WS_HN), (const bf16*)(ws + WS_WOUT0), NTOK, DM, DM, G, bx, (unsigned*)(ws + WS_CTL) + CW_OPT0);
        pg8::EpiResBf16<true> E{(const void*)args.in<0>(), (bf16*)(ws + WS_XB), DM};
        pg8::gemm_phase<pg8::EpiResBf16<true>, pg8::DenseSched, false>(lds, DM, S, E); }
    if (IN(6)) { phase_router(args, lds, 0, vcu, G); SEAM(6); }
    if (IN(7)) { phase_moe_gemm(args, lds, 0, 0, G); }
    if (IN(8)) { phase_moe_gemm(args, lds, 0, 1, G); SEAM(8); }
    if (IN(9)) { phase_prep1(args, lds, vcu, G); SEAM(9); }
    if (IN(10)) { ml::mlstm_gate_stats(args, vcu, G); pg8::DenseSched S; S.init((const bf16*)args.out, (const bf16*)(ws + WS_WIN1), NTOK, NU, DM, G, bx);
        pg8::EpiBf16RowScale E{(bf16*)(ws + WS_U), NU, (const float*)(ws + WS_RSTD1)};
        pg8::gemm_phase<pg8::EpiBf16RowScale, pg8::DenseSched, false>(lds, DM, S, E); SEAM(10); }
    if (IN(11)) { ml::phase_mlstm_pre(args, vcu, G); xcd_barrier(xbar); ml::phase_mlstm(args, lds, (int)(uintptr_t)lds_raw, vcu, G); SEAM(11); }
    if (IN(12)) { phase_post_mix1(args, vcu, G); SEAM(12); }
    if (IN(13)) { pg8::DenseSched S; S.init((const bf16*)(ws + WS_HN), (const bf16*)(ws + WS_WOUT1), NTOK, DM, DM, G, bx, (unsigned*)(ws + WS_CTL) + CW_OPT1);
        pg8::EpiResBf16<false> E{(const void*)args.out, (bf16*)(ws + WS_XB), DM};
        pg8::gemm_phase<pg8::EpiResBf16<false>, pg8::DenseSched, false>(lds, DM, S, E); }
    if (IN(14)) { phase_router(args, lds, 1, vcu, G); SEAM(14); }
    if (IN(15)) { phase_moe_gemm(args, lds, 1, 0, G); }
    if (IN(16)) { phase_moe_gemm(args, lds, 1, 1, G); SEAM(16); }
    if (IN(17)) { const int tid17 = opaque_tid(), lane = tid17 & 63, gw = vcu * NWAVES + (tid17 >> 6), ngw = G * NWAVES;
        const bf16* X3 = (const bf16*)(ws + WS_XB); const bf16* Y = (const bf16*)(ws + WS_Y);
        u32x2 xw[4], y0[4], y1[4];
        load_row_bf16(X3 + (size_t)gw * DM, lane, xw); load_row_bf16(Y + (size_t)(2 * gw) * DM, lane, y0); load_row_bf16(Y + (size_t)(2 * gw + 1) * DM, lane, y1);
        for (int m = gw; m < NTOK; m += ngw) { f32x4 v[4];
#pragma unroll
            for (int j = 0; j < 4; ++j) v[j] = (f32x4){bflo(xw[j].x), bfhi(xw[j].x), bflo(xw[j].y), bfhi(xw[j].y)};
            add_row_bf16(v, y0); add_row_bf16(v, y1);
            if (m + ngw < NTOK) { const size_t mn = (size_t)(m + ngw); load_row_bf16(X3 + mn * DM, lane, xw); load_row_bf16(Y + 2 * mn * DM, lane, y0); load_row_bf16(Y + (2 * mn + 1) * DM, lane, y1); }
#pragma unroll
            for (int j = 0; j < 4; ++j) *(f32x4*)(args.out + (size_t)m * DM + 4 * lane + 256 * j) = v[j]; } }
#undef IN
#undef SEAM
}

extern "C" void kernel_launch(void* const* d_in, const int* in_sizes, int n_in, void* d_out, int out_size, void* d_ws, size_t ws_size, hipStream_t stream) {
    static int grid = 0;
    if (grid == 0) {
        if (n_in != 34 || in_sizes[0] != NTOK * DM || out_size != NTOK * DM || ws_size < WS_END) {
            fprintf(stderr, "kernel_launch: shape/workspace mismatch: n_in %d in0 %d out %d ws %zu (need %zu)\n", n_in, n_in > 0 ? in_sizes[0] : -1, out_size, ws_size, (size_t)WS_END); grid = -1; return; }
        int dev = 0, cus = 0;
        if (hipGetDevice(&dev) != hipSuccess || hipDeviceGetAttribute(&cus, hipDeviceAttributeMultiprocessorCount, dev) != hipSuccess) { grid = -1; return; }
        if (hipFuncSetAttribute((const void*)fwd_kernel, hipFuncAttributeMaxDynamicSharedMemorySize, LDS_BYTES) != hipSuccess) { fprintf(stderr, "kernel_launch: hipFuncSetAttribute failed\n"); grid = -1; return; }
        int per_cu = 0;
        if (hipOccupancyMaxActiveBlocksPerMultiprocessor(&per_cu, (const void*)fwd_kernel, NTHR, LDS_BYTES) != hipSuccess || per_cu < 1) {
            fprintf(stderr, "kernel_launch: occupancy query reports %d blocks per CU; nothing launched\n", per_cu); (void)hipGetLastError(); grid = -1; return; }
        grid = cus;
    }
    if (grid < 0) return;
    (void)hipMemsetAsync((char*)d_ws + WS_CTL, 0, CTL_BYTES, stream);
    Args a{};
    for (int i = 0; i < 34; ++i) a.in[i] = (const float*)d_in[i];
    a.out = (float*)d_out; a.ws = (unsigned char*)d_ws;
#if MK_ONE
    a.ph_lo = 0; a.ph_hi = N_PHASES;
    void* kargs[] = {&a};
    hipError_t e = hipLaunchCooperativeKernel((const void*)fwd_kernel, dim3(grid), dim3(NTHR), kargs, LDS_BYTES, stream);
    if (e != hipSuccess) fprintf(stderr, "kernel_launch: cooperative launch failed: %s (grid %d)\n", hipGetErrorString(e), grid);
#else
    for (int p = 0; p < N_PHASES; ++p) {
        a.ph_lo = p; a.ph_hi = p + 1;
        hipLaunchKernelGGL(fwd_kernel, dim3(grid), dim3(NTHR), LDS_BYTES, stream, a);
    }
#endif
}
```
